# Optimizing an MI355X kernel written in HIP

```python
import jax
import jax.numpy as jnp
from jax import lax
import numpy as np

D_MODEL = 1024
BATCH = 4
SEQ = 4096
DEPTH = 1
DEC_BATCH = 8
DEC_SEQ = 8192
PAST_LEN = 128

HEAD_DIM = 64
ATTN_HEADS = 8
ATTN_WIDTH = ATTN_HEADS * HEAD_DIM
DILATION_PATTERNS = ((128, 1), (512, 4), (2048, 16))
ATTN_BLOCK = 64
ROPE_THETA = 10000.0
GLA_HEADS = 4
GLA_DK = 64
GLA_DV = 128
GLA_KW = GLA_HEADS * GLA_DK
GLA_VW = GLA_HEADS * GLA_DV
GLA_GATE_RANK = 16
GLA_TAU = 16.0
GLA_CHUNK = 64
MIX_WIDTH = ATTN_WIDTH + GLA_VW
D_FF = -(-8 * D_MODEL // (3 * 256)) * 256
EPS = 1e-6
MASK_VALUE = -1e30
SPLIT_SIZES = (ATTN_WIDTH, ATTN_WIDTH, ATTN_WIDTH, GLA_KW, GLA_KW, GLA_VW, GLA_VW, GLA_GATE_RANK, GLA_GATE_RANK)
IN_COLS = sum(SPLIT_SIZES)

kernel_name = "hybrid_dilated_attn_gla_encoder"


def rmsnorm(x, g):
    xf = x.astype(jnp.float32)
    y = xf * lax.rsqrt(jnp.mean(xf * xf, axis=-1, keepdims=True) + EPS)
    return (y * g.astype(jnp.float32)).astype(x.dtype)


def rope(x):
    s, dh = x.shape[1], x.shape[-1]
    inv_freq = ROPE_THETA ** (-jnp.arange(0, dh, 2, dtype=jnp.float32) / dh)
    ang = jnp.arange(s, dtype=jnp.float32)[:, None] * inv_freq[None, :]
    cos = jnp.cos(ang)[None, :, None, :]
    sin = jnp.sin(ang)[None, :, None, :]
    xf = x.astype(jnp.float32)
    x1, x2 = xf[..., : dh // 2], xf[..., dh // 2:]
    return jnp.concatenate([x1 * cos - x2 * sin, x2 * cos + x1 * sin], axis=-1).astype(x.dtype)


def dilated_pattern(q, k, v, window, dilation):
    b, s, h, dh = q.shape
    d = dilation
    half = window // (2 * d)
    L = s // d
    nb = -(-L // ATTN_BLOCK)
    lp = nb * ATTN_BLOCK

    def to_sub(t):
        t = t.reshape(b, L, d, h, dh).transpose(0, 2, 3, 1, 4)
        return jnp.pad(t, ((0, 0), (0, 0), (0, 0), (0, lp - L), (0, 0)))

    def neighbours(t):
        t = jnp.pad(to_sub(t), ((0, 0), (0, 0), (0, 0), (ATTN_BLOCK, ATTN_BLOCK), (0, 0)))
        t = t.reshape(b, d, h, nb + 2, ATTN_BLOCK, dh)
        return jnp.concatenate([t[:, :, :, :-2], t[:, :, :, 1:-1], t[:, :, :, 2:]], axis=4)

    qb = to_sub(q).reshape(b, d, h, nb, ATTN_BLOCK, dh)
    kb = neighbours(k)
    vb = neighbours(v)
    qpos = jnp.arange(nb)[:, None] * ATTN_BLOCK + jnp.arange(ATTN_BLOCK)[None, :]
    kpos = (jnp.arange(nb)[:, None] - 1) * ATTN_BLOCK + jnp.arange(3 * ATTN_BLOCK)[None, :]
    dist = kpos[:, None, :] - qpos[:, :, None]
    valid = (jnp.abs(dist) <= half) & (kpos[:, None, :] >= 0) & (kpos[:, None, :] < L)
    scores = jnp.einsum('bdhnqe,bdhnke->bdhnqk', qb, kb,
                        preferred_element_type=jnp.float32) * (dh ** -0.5)
    scores = jnp.where(valid, scores, MASK_VALUE)
    lse = jax.nn.logsumexp(scores, axis=-1)
    p = jnp.exp(scores - lse[..., None])
    o = jnp.einsum('bdhnqk,bdhnke->bdhnqe', p, vb.astype(jnp.float32))
    o = o.reshape(b, d, h, lp, dh)[:, :, :, :L].transpose(0, 3, 1, 2, 4).reshape(b, s, h, dh)
    lse = lse.reshape(b, d, h, lp)[..., :L].transpose(0, 3, 1, 2).reshape(b, s, h)
    return o, lse


def dilated_mixture(q, k, v):
    outs, lses = [], []
    for window, dilation in DILATION_PATTERNS:
        o, l = dilated_pattern(q, k, v, window, dilation)
        outs.append(o)
        lses.append(l)
    w = jax.nn.softmax(jnp.stack(lses, axis=0), axis=0)
    return jnp.sum(w[..., None] * jnp.stack(outs, axis=0), axis=0)


def gla_chunked(q, k, v, log_a, include_diag):
    b, h, s, dk = q.shape
    dv = v.shape[-1]
    n = s // GLA_CHUNK
    q = q.reshape(b, h, n, GLA_CHUNK, dk)
    k = k.reshape(b, h, n, GLA_CHUNK, dk)
    v = v.reshape(b, h, n, GLA_CHUNK, dv)
    cum = jnp.cumsum(log_a.reshape(b, h, n, GLA_CHUNK, dk), axis=3)
    cum_last = cum[:, :, :, -1:, :]
    q_e = q * jnp.exp(cum)
    k_e = k * jnp.exp(-cum)
    k_end = k * jnp.exp(cum_last - cum)
    tri = jnp.tril(jnp.ones((GLA_CHUNK, GLA_CHUNK), dtype=bool), 0 if include_diag else -1)
    attn = jnp.where(tri, jnp.einsum('bhnce,bhnse->bhncs', q_e, k_e), 0.0)
    o_intra = jnp.einsum('bhncs,bhnsv->bhncv', attn, v)
    chunk_kv = jnp.einsum('bhnse,bhnsv->bhnev', k_end, v)
    chunk_decay = jnp.exp(cum_last[:, :, :, 0])

    def step(state, inp):
        dec, kv = inp
        return state * dec[..., None] + kv, state

    init = jnp.zeros((b, h, dk, dv), jnp.float32)
    _, states = lax.scan(step, init, (jnp.moveaxis(chunk_decay, 2, 0), jnp.moveaxis(chunk_kv, 2, 0)))
    states = jnp.moveaxis(states, 0, 2)
    o_inter = jnp.einsum('bhnce,bhnev->bhncv', q_e, states)
    return (o_intra + o_inter).reshape(b, h, s, dv)


def hybrid_mixer(hn, w_in, gate_up_fwd, gate_bias_fwd, gate_up_bwd, gate_bias_bwd, gla_norm_g, w_out):
    b, s, _ = hn.shape
    f32 = jnp.float32
    proj = hn @ w_in
    idx = np.cumsum(SPLIT_SIZES)[:-1].tolist()
    qa, ka, va, qg, kg, vg, og, rf, rb = jnp.split(proj, idx, axis=-1)

    qa = rope(qa.reshape(b, s, ATTN_HEADS, HEAD_DIM))
    ka = rope(ka.reshape(b, s, ATTN_HEADS, HEAD_DIM))
    va = va.reshape(b, s, ATTN_HEADS, HEAD_DIM)
    attn = dilated_mixture(qa, ka, va).reshape(b, s, ATTN_WIDTH)

    def to_bhsd(t):
        return t.reshape(b, s, GLA_HEADS, -1).transpose(0, 2, 1, 3).astype(f32)

    def log_decay(r, up, bias):
        z = jnp.einsum('bsr,rk->bsk', r.astype(f32), up.astype(f32)) + bias.astype(f32)
        return to_bhsd(jax.nn.log_sigmoid(z) / GLA_TAU)

    qg = to_bhsd(qg) * (GLA_DK ** -0.5)
    kg = to_bhsd(kg)
    vg = to_bhsd(vg)
    la_f = log_decay(rf, gate_up_fwd, gate_bias_fwd)
    la_b = log_decay(rb, gate_up_bwd, gate_bias_bwd)
    fwd = gla_chunked(qg, kg, vg, la_f, True)
    flip = lambda t: jnp.flip(t, axis=2)
    bwd = flip(gla_chunked(flip(qg), flip(kg), flip(vg), flip(la_b), False))
    o = (fwd + bwd).transpose(0, 2, 1, 3)
    o = o * lax.rsqrt(jnp.mean(o * o, axis=-1, keepdims=True) + EPS)
    o = o * gla_norm_g.astype(f32).reshape(GLA_HEADS, GLA_DV)
    gla = o.reshape(b, s, GLA_VW) * jax.nn.silu(og.astype(f32))

    mixed = jnp.concatenate([attn, gla], axis=-1).astype(hn.dtype)
    return mixed @ w_out


def swiglu(hn, w_gate, w_up, w_down):
    return (jax.nn.silu(hn @ w_gate) * (hn @ w_up)) @ w_down


def trunk(x, norm1_g, w_in, gate_up_fwd, gate_bias_fwd, gate_up_bwd, gate_bias_bwd,
          gla_norm_g, w_out, norm2_g, w_gate, w_up, w_down, final_norm_g):
    for l in range(DEPTH):
        x = x + hybrid_mixer(rmsnorm(x, norm1_g[l]), w_in[l], gate_up_fwd[l], gate_bias_fwd[l],
                             gate_up_bwd[l], gate_bias_bwd[l], gla_norm_g[l], w_out[l])
        x = x + swiglu(rmsnorm(x, norm2_g[l]), w_gate[l], w_up[l], w_down[l])
    return rmsnorm(x, final_norm_g)


def setup_inputs(seed: int = 0) -> dict:
    key = jax.random.key(seed)
    ks = jax.random.split(key, 16)
    f32 = jnp.float32
    nrm = lambda k, shape, scale: jax.random.normal(k, shape, f32) * scale
    return {
        "x_prompt": nrm(ks[0], (BATCH, SEQ, D_MODEL), 1.0),
        "x_sample": nrm(ks[1], (DEC_BATCH, DEC_SEQ, D_MODEL), 1.0),
        "norm1_g": 1.0 + nrm(ks[2], (DEPTH, D_MODEL), 0.02),
        "w_in": nrm(ks[3], (DEPTH, D_MODEL, IN_COLS), D_MODEL ** -0.5),
        "gate_up_fwd": nrm(ks[4], (DEPTH, GLA_GATE_RANK, GLA_KW), GLA_GATE_RANK ** -0.5),
        "gate_bias_fwd": nrm(ks[5], (DEPTH, GLA_KW), 0.1),
        "gate_up_bwd": nrm(ks[6], (DEPTH, GLA_GATE_RANK, GLA_KW), GLA_GATE_RANK ** -0.5),
        "gate_bias_bwd": nrm(ks[7], (DEPTH, GLA_KW), 0.1),
        "gla_norm_g": 1.0 + nrm(ks[8], (DEPTH, GLA_VW), 0.02),
        "w_out": nrm(ks[9], (DEPTH, MIX_WIDTH, D_MODEL), MIX_WIDTH ** -0.5),
        "norm2_g": 1.0 + nrm(ks[10], (DEPTH, D_MODEL), 0.02),
        "w_gate": nrm(ks[11], (DEPTH, D_MODEL, D_FF), D_MODEL ** -0.5),
        "w_up": nrm(ks[12], (DEPTH, D_MODEL, D_FF), D_MODEL ** -0.5),
        "w_down": nrm(ks[13], (DEPTH, D_FF, D_MODEL), D_FF ** -0.5),
        "final_norm_g": 1.0 + nrm(ks[14], (D_MODEL,), 0.02),
    }


def reference(x_prompt, x_sample, norm1_g, w_in, gate_up_fwd, gate_bias_fwd, gate_up_bwd, gate_bias_bwd,
              gla_norm_g, w_out, norm2_g, w_gate, w_up, w_down, final_norm_g):
    y_prompt = trunk(x_prompt, norm1_g, w_in, gate_up_fwd, gate_bias_fwd, gate_up_bwd, gate_bias_bwd,
                     gla_norm_g, w_out, norm2_g, w_gate, w_up, w_down, final_norm_g)
    y_sample = trunk(x_sample, norm1_g, w_in, gate_up_fwd, gate_bias_fwd, gate_up_bwd, gate_bias_bwd,
                     gla_norm_g, w_out, norm2_g, w_gate, w_up, w_down, final_norm_g)
    return (y_prompt, y_sample)
```

```cpp
#include <hip/hip_runtime.h>
#include <hip/hip_bf16.h>
#include <cstdio>
#include <cstdint>
#include <cmath>

#ifndef MK_N_LAUNCHES
#define MK_N_LAUNCHES 9
#endif

constexpr int DM = 1024;
constexpr int MP = 4 * 4096;
constexpr int MS = 8 * 8192;
constexpr int MT = MP + MS;
constexpr int NIN = 3104, NINP = 3328;
constexpr int DFF = 2816;
constexpr int NCHUNK = MT / 64;
constexpr float EPS = 1e-6f;
constexpr float QSCALE = 0.125f * 1.4426950408889634f;

constexpr size_t MiB = 1u << 20;
constexpr size_t WS_CTL = 0, CTL_ZERO_BYTES = 1 * MiB;
constexpr size_t WS_SS1 = 128 * 1024, WS_SS2 = 512 * 1024;
constexpr size_t WS_WIN = 1 * MiB;
constexpr size_t WS_WOUT = 8 * MiB;
constexpr size_t WS_WGU = 10 * MiB;
constexpr size_t WS_WDN = 21 * MiB;
constexpr size_t WS_ROPE = 27 * MiB;
constexpr size_t WS_DECAY = 29 * MiB;
constexpr size_t WS_MIX = 32 * MiB;
constexpr size_t WS_HN = 192 * MiB;
constexpr size_t WS_KA = 352 * MiB, WS_VA = 432 * MiB;
constexpr size_t WS_VG = 512 * MiB, WS_OG = 592 * MiB;
constexpr size_t WS_QE = 672 * MiB;
constexpr size_t WS_RFB = 832 * MiB;
constexpr size_t WS_ATT = 848 * MiB;
constexpr size_t WS_H = 352 * MiB;
constexpr size_t WS_END = 896 * MiB;
constexpr size_t QE_STRIDE = (size_t)MT * 256;
constexpr int ATT_SCR_FLOATS = 512 * 64 + 1024;
static_assert(WS_H + (size_t)MT * DFF * 2 <= WS_RFB && WS_ATT + (size_t)256 * ATT_SCR_FLOATS * 4 <= WS_END, "ws map");
constexpr int CW_BAR = 4096;

constexpr int LDS_BYTES = 163840;
constexpr int MISC_OFF = LDS_BYTES - 256;
constexpr int G_VT = 0, G_VT_HEAD = 64 * 288;
constexpr int G_KE = 4 * G_VT_HEAD;
constexpr int G_RF = G_KE + 8 * 9216;
constexpr int G_CL = G_RF + 8192;
static_assert(G_CL + 2048 <= MISC_OFF, "lds map");
namespace pg8 {
#define PG8_LAS __attribute__((address_space(3)))
typedef unsigned short bf16_t;
typedef short bf16x8 __attribute__((ext_vector_type(8)));
typedef float f32x4 __attribute__((ext_vector_type(4)));
typedef unsigned u32x4 __attribute__((ext_vector_type(4)));
constexpr int BM = 256, BK = 64, HALF = 128, HTB = HALF * BK * 2  , STAGE_BYTES = 8 * HTB, NXCD = 8, WGM = 8;

__host__ __device__ __forceinline__ int lds_byte(int r, int c) { const int st = (r >> 4) * 2 + (c >> 5), rr = r & 15, cc = c & 31, ob = rr * 64 + cc * 2; return st * 1024 + (ob ^ (((ob >> 9) & 1) << 5)); }
__host__ __device__ __forceinline__ void stage_rc(int b, int& R, int& C) { const int st = b / 1024, sb = b % 1024, swz = sb ^ (((sb >> 9) & 1) << 5); R = (st >> 1) * 16 + swz / 64; C = (st & 1) * 32 + (swz % 64) / 2; }
__host__ __device__ __forceinline__ int perm32(int rho) { const int n = rho >> 4, i = rho & 15; return 8 * (i >> 2) + 4 * n + (i & 3); }

struct Unit { int pm, pn; };
struct Gemm { const bf16_t* A; const bf16_t* Bt; int M, N, K; };

struct StaticOrder {
    int nM, nN, nwg, G, c;
    __host__ __device__ void init(int M, int N, int G_, int c_) { nM = M / BM; nN = N / BM; nwg = nM * nN; G = G_; c = c_; }
    __host__ __device__ bool next(int i, Unit& u) const {
        const long L = (long)i * G + c; if (L >= nwg) return false;
        int wgid = (int)L; { const int q = nwg / NXCD, r = nwg % NXCD, xcd = wgid % NXCD, off = wgid / NXCD; wgid = (xcd < r ? xcd * (q + 1) : r * (q + 1) + (xcd - r) * q) + off; }
        const int nig = WGM * nN, gid = wgid / nig, fm = gid * WGM, gsz = (nM - fm) < WGM ? (nM - fm) : WGM;
        u.pm = fm + ((wgid % nig) % gsz); u.pn = (wgid % nig) / gsz; return true;
    }
    __device__ __forceinline__ void a_ready(const Unit&) const {}
    __device__ __forceinline__ void done(const Unit&) const {}
};

__device__ __forceinline__ unsigned cvt_pk_bf16(float lo, float hi) { unsigned r; asm volatile("v_cvt_pk_bf16_f32 %0, %1, %2" : "=v"(r) : "v"(lo), "v"(hi)); return r; }
typedef float f32x2 __attribute__((ext_vector_type(2)));
typedef unsigned u32x2 __attribute__((ext_vector_type(2)));
__device__ __forceinline__ float silu_f(float x) { return x * __builtin_amdgcn_rcpf(1.0f + __builtin_amdgcn_exp2f(-1.4426950408889634f * x)); }
__device__ __forceinline__ int seq_pos(int row) { return row < MP ? (row & 4095) : (row & 8191); }

struct EpiInProj {
    static constexpr bool PERM = true, AFTER_DRAIN = false;
    bf16_t* mix; bf16_t* ka; bf16_t* va; bf16_t* vg; bf16_t* og; float* rfb; const float* ropec; const float* ropes;
    __device__ __forceinline__ void operator()(const f32x4 (&acc)[2][2][4][2], const Unit& u, int wr, int wc, int fr, int fq) const {
        const int pn = u.pn, row0 = u.pm * BM + wr * 64 + fr;
        if (pn < 4) {
            bf16_t* dst; int pitch; float sc;
            if (pn < 2) { dst = mix + pn * 256; pitch = 1024; sc = QSCALE; } else { dst = ka + (pn - 2) * 256; pitch = 512; sc = 1.0f; }
            const int d0 = 16 * (wc & 1) + 4 * fq;
#pragma unroll
            for (int ai = 0; ai < 2; ++ai)
#pragma unroll
                for (int m = 0; m < 4; ++m) {
                    const int row = row0 + ai * HALF + m * 16, s = seq_pos(row);
                    const f32x4 cs = *(const f32x4*)(ropec + s * 32 + d0), sn = *(const f32x4*)(ropes + s * 32 + d0);
#pragma unroll
                    for (int bj = 0; bj < 2; ++bj) {
                        const f32x4 x1 = acc[ai][bj][m][0], x2 = acc[ai][bj][m][1];
                        const f32x4 o1 = (x1 * cs - x2 * sn) * sc, o2 = (x2 * cs + x1 * sn) * sc;
                        bf16_t* p = dst + (size_t)row * pitch + 64 * (2 * bj + (wc >> 1)) + d0;
                        u32x2 w1, w2; w1.x = cvt_pk_bf16(o1[0], o1[1]); w1.y = cvt_pk_bf16(o1[2], o1[3]); w2.x = cvt_pk_bf16(o2[0], o2[1]); w2.y = cvt_pk_bf16(o2[2], o2[3]);
                        *(u32x2*)p = w1; *(u32x2*)(p + 32) = w2;
                    }
                }
        } else if (pn < 12) {
            bf16_t* dst; int pitch; float sc = 1.0f; bool act = false;
            if (pn < 6) { dst = va + (pn - 4) * 256; pitch = 512; }
            else if (pn == 6) { dst = mix + 512; pitch = 1024; sc = 0.125f; }
            else if (pn == 7) { dst = mix + 768; pitch = 1024; }
            else if (pn < 10) { dst = vg + (pn - 8) * 256; pitch = 512; }
            else { dst = og + (pn - 10) * 256; pitch = 512; act = true; }
            const int col0 = wc * 32 + 8 * fq;
#pragma unroll
            for (int ai = 0; ai < 2; ++ai)
#pragma unroll
                for (int m = 0; m < 4; ++m) {
                    bf16_t* rowp = dst + (size_t)(row0 + ai * HALF + m * 16) * pitch + col0;
#pragma unroll
                    for (int bj = 0; bj < 2; ++bj) {
                        f32x4 v0 = acc[ai][bj][m][0] * sc, v1 = acc[ai][bj][m][1] * sc;
                        if (act) { v0 = (f32x4){silu_f(v0[0]), silu_f(v0[1]), silu_f(v0[2]), silu_f(v0[3])}; v1 = (f32x4){silu_f(v1[0]), silu_f(v1[1]), silu_f(v1[2]), silu_f(v1[3])}; }
                        u32x4 w; w.x = cvt_pk_bf16(v0[0], v0[1]); w.y = cvt_pk_bf16(v0[2], v0[3]); w.z = cvt_pk_bf16(v1[0], v1[1]); w.w = cvt_pk_bf16(v1[2], v1[3]);
                        *(u32x4*)(rowp + bj * HALF) = w;
                    }
                }
        } else {
            if (wc == 0) {
#pragma unroll
                for (int ai = 0; ai < 2; ++ai)
#pragma unroll
                    for (int m = 0; m < 4; ++m) {
                        float* rowp = rfb + (size_t)(row0 + ai * HALF + m * 16) * 32 + 8 * fq;
                        *(f32x4*)rowp = acc[ai][0][m][0]; *(f32x4*)(rowp + 4) = acc[ai][0][m][1];
                    }
            }
        }
    }
};

struct EpiOutProj {
    static constexpr bool PERM = false, AFTER_DRAIN = false;
    const float* xp; const float* xs; float* out; bf16_t* x1b; float* ss;
    __device__ __forceinline__ void operator()(const f32x4 (&acc)[2][2][4][2], const Unit& u, int wr, int wc, int fr, int fq) const {
        const int row0 = u.pm * BM + wr * 64 + fr, col0 = u.pn * BM + wc * 32 + 4 * fq;
#pragma unroll
        for (int ai = 0; ai < 2; ++ai)
#pragma unroll
            for (int m = 0; m < 4; ++m) {
                const int row = row0 + ai * HALF + m * 16;
                const float* xr = (row < MP ? xp + (size_t)row * DM : xs + (size_t)(row - MP) * DM) + col0;
                float* orow = out + (size_t)row * DM + col0; bf16_t* brow = x1b + (size_t)row * DM + col0;
                float q = 0.f;
#pragma unroll
                for (int bj = 0; bj < 2; ++bj)
#pragma unroll
                    for (int n = 0; n < 2; ++n) {
                        const f32x4 v = acc[ai][bj][m][n] + *(const f32x4*)(xr + bj * HALF + n * 16);
                        *(f32x4*)(orow + bj * HALF + n * 16) = v;
                        u32x2 w; w.x = cvt_pk_bf16(v[0], v[1]); w.y = cvt_pk_bf16(v[2], v[3]); *(u32x2*)(brow + bj * HALF + n * 16) = w;
                        q += (v[0] * v[0] + v[1] * v[1]) + (v[2] * v[2] + v[3] * v[3]);
                    }
                q += __shfl_xor(q, 16); q += __shfl_xor(q, 32);
                if (fq == 0) atomicAdd(ss + row, q);
            }
    }
};

struct EpiFfn1 {
    static constexpr bool PERM = true, AFTER_DRAIN = false;
    bf16_t* h; const float* ss;
    __device__ __forceinline__ void operator()(const f32x4 (&acc)[2][2][4][2], const Unit& u, int wr, int wc, int fr, int fq) const {
        const int row0 = u.pm * BM + wr * 64 + fr, col0 = u.pn * HALF + wc * 32 + 8 * fq;
#pragma unroll
        for (int ai = 0; ai < 2; ++ai)
#pragma unroll
            for (int m = 0; m < 4; ++m) {
                const int row = row0 + ai * HALF + m * 16;
                const float r = __builtin_amdgcn_rsqf(__hip_atomic_load(ss + row, __ATOMIC_RELAXED, __HIP_MEMORY_SCOPE_AGENT) * (1.0f / DM) + EPS);
                float o[8];
#pragma unroll
                for (int n = 0; n < 2; ++n)
#pragma unroll
                    for (int e = 0; e < 4; ++e) o[4 * n + e] = silu_f(acc[ai][0][m][n][e] * r) * (acc[ai][1][m][n][e] * r);
                u32x4 w; w.x = cvt_pk_bf16(o[0], o[1]); w.y = cvt_pk_bf16(o[2], o[3]); w.z = cvt_pk_bf16(o[4], o[5]); w.w = cvt_pk_bf16(o[6], o[7]);
                *(u32x4*)(h + (size_t)row * DFF + col0) = w;
            }
    }
};

struct EpiFfn2 {
    static constexpr bool PERM = false, AFTER_DRAIN = false;
    float* out; float* ss;
    __device__ __forceinline__ void operator()(const f32x4 (&acc)[2][2][4][2], const Unit& u, int wr, int wc, int fr, int fq) const {
        const int row0 = u.pm * BM + wr * 64 + fr, col0 = u.pn * BM + wc * 32 + 4 * fq;
#pragma unroll
        for (int ai = 0; ai < 2; ++ai)
#pragma unroll
            for (int m = 0; m < 4; ++m) {
                const int row = row0 + ai * HALF + m * 16;
                float* orow = out + (size_t)row * DM + col0;
                float q = 0.f;
#pragma unroll
                for (int bj = 0; bj < 2; ++bj)
#pragma unroll
                    for (int n = 0; n < 2; ++n) {
                        const f32x4 v = acc[ai][bj][m][n] + *(const f32x4*)(orow + bj * HALF + n * 16);
                        *(f32x4*)(orow + bj * HALF + n * 16) = v;
                        q += (v[0] * v[0] + v[1] * v[1]) + (v[2] * v[2] + v[3] * v[3]);
                    }
                q += __shfl_xor(q, 16); q += __shfl_xor(q, 32);
                if (fq == 0) atomicAdd(ss + row, q);
            }
    }
};

template <class Epi, class Sched, bool ALIGN_EPI = false, bool SP2 = false>
__device__ __forceinline__ void gemm_phase(PG8_LAS unsigned char* lds, const Gemm g, const Sched& S, const Epi& E) {
    const int tid = threadIdx.x, wid = __builtin_amdgcn_readfirstlane(tid >> 6), lane = tid & 63, wr = wid >> 2, wc = wid & 3, fr = lane & 15, fq = lane >> 4;
    const int K = g.K, nt = K / BK;
    unsigned voffA[2], voffB[2];
#pragma unroll
    for (int i = 0; i < 2; ++i) { int R, C; stage_rc(tid * 16 + i * 8192, R, C); const int Rb = Epi::PERM ? ((R & ~31) + perm32(R & 31)) : R;
        voffA[i] = (unsigned)(R * K + C) * 2u; voffB[i] = (unsigned)(Rb * K + C) * 2u; }
    const size_t kstep = (size_t)(BK * 2);
    const size_t hstep = (size_t)HALF * K * 2;
    const size_t tstep = 2 * hstep;
    const unsigned ldsw = (unsigned)wid * 1024u;
    const int aoff = lds_byte(wr * 64 + fr, fq * 8), boff = lds_byte(wc * 32 + fr, fq * 8);
#define PG8_SA(b, h) (((b) * 2 + (h)) * HTB)
#define PG8_SB(b, h) ((4 + (b) * 2 + (h)) * HTB)
#define PG8_STAGE(bufoff, gbase, voff) do { _Pragma("unroll") for (int _i = 0; _i < 2; ++_i) \
        __builtin_amdgcn_global_load_lds((const unsigned*)((const char*)(gbase) + (voff)[_i]), (PG8_LAS unsigned*)(lds + (bufoff) + ldsw + _i * 8192), 16, 0, 0); } while (0)
#define PG8_LDA(dst, b, h) do { _Pragma("unroll") for (int m = 0; m < 4; ++m) _Pragma("unroll") for (int k = 0; k < 2; ++k) dst[m][k] = *(const PG8_LAS bf16x8*)(lds + PG8_SA(b, h) + aoff + m * 2048 + k * 1024); } while (0)
#define PG8_LDB(dst, b, h) do { _Pragma("unroll") for (int n = 0; n < 2; ++n) _Pragma("unroll") for (int k = 0; k < 2; ++k) dst[n][k] = *(const PG8_LAS bf16x8*)(lds + PG8_SB(b, h) + boff + n * 2048 + k * 1024); } while (0)
#define PG8_MMA(ai, bj, At, Bt) do { __builtin_amdgcn_s_setprio(1); _Pragma("unroll") for (int m = 0; m < 4; ++m) _Pragma("unroll") for (int n = 0; n < 2; ++n) _Pragma("unroll") for (int k = 0; k < 2; ++k) \
        acc[ai][bj][m][n] = __builtin_amdgcn_mfma_f32_16x16x32_bf16(Bt[n][k], At[m][k], acc[ai][bj][m][n], 0, 0, 0); __builtin_amdgcn_s_setprio(0); } while (0)
#define PG8_WAIT_V(n) asm volatile("s_waitcnt vmcnt(" #n ")" ::: "memory")
#define PG8_WAIT_L(n) asm volatile("s_waitcnt lgkmcnt(" #n ")" ::: "memory")
#define PG8_BAR __builtin_amdgcn_s_barrier()
#define PG8_SCHED __builtin_amdgcn_sched_barrier(0)
    Unit cur, nxt; int ui = 0;
    if (!S.next(0, cur)) return;
    f32x4 acc[2][2][4][2];
#pragma unroll
    for (int a = 0; a < 2; ++a)
#pragma unroll
        for (int b = 0; b < 2; ++b)
#pragma unroll
            for (int m = 0; m < 4; ++m)
#pragma unroll
                for (int n = 0; n < 2; ++n) acc[a][b][m][n] = (f32x4){0.f, 0.f, 0.f, 0.f};
    bf16x8 At[4][2], B0[2][2], B1[2][2];
    const char* cA = (const char*)g.A + (size_t)cur.pm * tstep; const char* cB = (const char*)g.Bt + (size_t)cur.pn * tstep;
    S.a_ready(cur);
    if constexpr (SP2) {
        PG8_STAGE(PG8_SB(0, 0), cB, voffB); PG8_STAGE(PG8_SB(0, 1), cB + hstep, voffB); PG8_STAGE(PG8_SA(0, 0), cA, voffA); PG8_STAGE(PG8_SA(0, 1), cA + hstep, voffA);
        if (wr == 1) PG8_BAR;
        PG8_WAIT_V(2); PG8_BAR;
        PG8_STAGE(PG8_SB(1, 0), cB + kstep, voffB); PG8_STAGE(PG8_SA(1, 0), cA + kstep, voffA); PG8_STAGE(PG8_SB(1, 1), cB + hstep + kstep, voffB);
        PG8_WAIT_V(6); PG8_BAR;
    } else {
        PG8_STAGE(PG8_SB(0, 0), cB, voffB); PG8_STAGE(PG8_SA(0, 0), cA, voffA); PG8_STAGE(PG8_SB(0, 1), cB + hstep, voffB); PG8_STAGE(PG8_SA(0, 1), cA + hstep, voffA);
        if (wr == 1) PG8_BAR;
        PG8_WAIT_V(4); PG8_BAR;
        PG8_STAGE(PG8_SB(1, 0), cB + kstep, voffB); PG8_STAGE(PG8_SA(1, 0), cA + kstep, voffA); PG8_STAGE(PG8_SB(1, 1), cB + hstep + kstep, voffB);
        PG8_WAIT_V(6); PG8_BAR;
    }
    for (;;) {
        const bool has_next = S.next(ui + 1, nxt);
        const char* nA = has_next ? (const char*)g.A + (size_t)nxt.pm * tstep : cA; const char* nB = has_next ? (const char*)g.Bt + (size_t)nxt.pn * tstep : cB;
        for (int t = 0; t < nt; t += 2) {
            const bool last = (t == nt - 2);
            const char* a1 = cA + (size_t)(t + 1) * kstep;
            const char* a2 = last ? nA : cA + (size_t)(t + 2) * kstep; const char* b2 = last ? nB : cB + (size_t)(t + 2) * kstep;
            const char* a3 = a2 + kstep; const char* b3 = b2 + kstep;
            if (last && has_next) S.a_ready(nxt);
            if constexpr (SP2) {
            PG8_LDB(B0, 0, 0); PG8_LDB(B1, 0, 1); PG8_SCHED; PG8_LDA(At, 0, 0); PG8_STAGE(PG8_SA(1, 1), a1 + hstep, voffA);
            PG8_WAIT_V(8); PG8_WAIT_L(0); PG8_BAR; PG8_MMA(0, 0, At, B0); PG8_MMA(0, 1, At, B1); PG8_BAR; PG8_SCHED;
            PG8_LDA(At, 0, 1); PG8_STAGE(PG8_SB(0, 0), b2, voffB); PG8_STAGE(PG8_SB(0, 1), b2 + hstep, voffB); PG8_STAGE(PG8_SA(0, 0), a2, voffA);
            PG8_WAIT_V(8); PG8_WAIT_L(0); PG8_BAR; PG8_MMA(1, 0, At, B0); PG8_MMA(1, 1, At, B1); PG8_BAR; PG8_SCHED;
            PG8_LDB(B0, 1, 0); PG8_LDB(B1, 1, 1); PG8_SCHED; PG8_LDA(At, 1, 0); PG8_STAGE(PG8_SA(0, 1), a2 + hstep, voffA);
            PG8_WAIT_V(8); PG8_WAIT_L(0); PG8_BAR; PG8_MMA(0, 0, At, B0); PG8_MMA(0, 1, At, B1); PG8_BAR; PG8_SCHED;
            PG8_LDA(At, 1, 1); PG8_STAGE(PG8_SB(1, 0), b3, voffB); PG8_STAGE(PG8_SB(1, 1), b3 + hstep, voffB); PG8_STAGE(PG8_SA(1, 0), a3, voffA);
            PG8_WAIT_V(8); PG8_WAIT_L(0); PG8_BAR; PG8_MMA(1, 0, At, B0); PG8_MMA(1, 1, At, B1); PG8_BAR; PG8_SCHED;
            } else {
            PG8_LDB(B0, 0, 0); PG8_SCHED; PG8_LDA(At, 0, 0); PG8_STAGE(PG8_SA(1, 1), a1 + hstep, voffA);
            PG8_WAIT_L(8); PG8_BAR; PG8_WAIT_L(0); PG8_MMA(0, 0, At, B0); PG8_BAR; PG8_SCHED;
            PG8_LDB(B1, 0, 1); PG8_STAGE(PG8_SB(0, 0), b2, voffB);
            PG8_BAR; PG8_WAIT_L(0); PG8_MMA(0, 1, At, B1); PG8_BAR;
            PG8_LDA(At, 0, 1); PG8_STAGE(PG8_SA(0, 0), a2, voffA);
            PG8_BAR; PG8_WAIT_L(0); PG8_MMA(1, 0, At, B0); PG8_BAR; PG8_SCHED;
            PG8_STAGE(PG8_SB(0, 1), b2 + hstep, voffB);
            PG8_WAIT_V(6); PG8_BAR; PG8_MMA(1, 1, At, B1); PG8_BAR;
            PG8_LDB(B0, 1, 0); PG8_SCHED; PG8_LDA(At, 1, 0); PG8_STAGE(PG8_SA(0, 1), a2 + hstep, voffA);
            PG8_WAIT_L(8); PG8_BAR; PG8_WAIT_L(0); PG8_MMA(0, 0, At, B0); PG8_BAR; PG8_SCHED;
            PG8_LDB(B1, 1, 1); PG8_STAGE(PG8_SB(1, 0), b3, voffB);
            PG8_BAR; PG8_WAIT_L(0); PG8_MMA(0, 1, At, B1); PG8_BAR;
            PG8_LDA(At, 1, 1); PG8_STAGE(PG8_SA(1, 0), a3, voffA);
            PG8_BAR; PG8_WAIT_L(0); PG8_MMA(1, 0, At, B0); PG8_BAR; PG8_SCHED;
            PG8_STAGE(PG8_SB(1, 1), b3 + hstep, voffB);
            PG8_WAIT_V(6); PG8_BAR; PG8_MMA(1, 1, At, B1); PG8_BAR;
            }
        }
        if constexpr (ALIGN_EPI) { if (wr == 0) PG8_BAR; }
        if constexpr (!Epi::AFTER_DRAIN) { E(acc, cur, wr, wc, fr, fq); S.done(cur); }
        if (!has_next) break;
#pragma unroll
        for (int a = 0; a < 2; ++a)
#pragma unroll
            for (int b = 0; b < 2; ++b)
#pragma unroll
                for (int m = 0; m < 4; ++m)
#pragma unroll
                    for (int n = 0; n < 2; ++n) acc[a][b][m][n] = (f32x4){0.f, 0.f, 0.f, 0.f};
        cur = nxt; cA = nA; cB = nB; ++ui;
        if constexpr (ALIGN_EPI) { if (wr == 1) PG8_BAR; }
    }
    PG8_WAIT_V(0);
    if constexpr (!ALIGN_EPI) { if (wr == 0) PG8_BAR; }
    PG8_BAR;
    if constexpr (Epi::AFTER_DRAIN) { E.fused(acc, cur, wr, wc, fr, fq, lds, wid, lane); S.done(cur); }
#undef PG8_SA
#undef PG8_SB
#undef PG8_STAGE
#undef PG8_LDA
#undef PG8_LDB
#undef PG8_MMA
#undef PG8_WAIT_V
#undef PG8_WAIT_L
#undef PG8_BAR
#undef PG8_SCHED
}
}
#define GAS __attribute__((address_space(1)))
#define LAS __attribute__((address_space(3)))
typedef unsigned short bf16;
typedef unsigned v4u __attribute__((ext_vector_type(4)));
typedef float f32x4 __attribute__((ext_vector_type(4)));
typedef short bf16x8 __attribute__((ext_vector_type(8)));
typedef GAS unsigned gu32;
typedef GAS unsigned long long gu64;
#define RLX_AGENT __ATOMIC_RELAXED, __HIP_MEMORY_SCOPE_AGENT
#define LDS_WAIT() asm volatile("s_waitcnt lgkmcnt(0)" ::: "memory")
#define VM_WAIT() asm volatile("s_waitcnt vmcnt(0)" ::: "memory")
__device__ __forceinline__ unsigned long long rt() { return __builtin_amdgcn_s_memrealtime(); }
__device__ __forceinline__ unsigned f2bf(float f) { unsigned u = __builtin_bit_cast(unsigned, f); return (u + 0x7fffu + ((u >> 16) & 1u)) >> 16; }
__device__ __forceinline__ unsigned pk2(float lo, float hi) { return f2bf(lo) | (f2bf(hi) << 16); }

#define XB_TMO      128
#define XB_XCNT(j)  (256  + 64 * (j))
#define XB_XSUB(j)  (1280 + 64 * (j))
#define XB_XGEN(j)  (2304 + 64 * (j))
#define XB_TOP      3328
#define XB_TOPGEN   3392
#define XCD_BAR_WORDS 3456
#define XB_SPIN_CAP (1u << 18)

__device__ __forceinline__ unsigned xb_ld(unsigned* p)              { return __hip_atomic_load(p, __ATOMIC_RELAXED, __HIP_MEMORY_SCOPE_AGENT); }
__device__ __forceinline__ unsigned xb_add(unsigned* p, unsigned v) { return __hip_atomic_fetch_add(p, v, __ATOMIC_RELAXED, __HIP_MEMORY_SCOPE_AGENT); }
__device__ __forceinline__ unsigned xb_xcc_id() { return (unsigned)__builtin_amdgcn_s_getreg((3 << 11) | 20) & 0xFu; }
#define XB_SPIN(cond, bar) do { unsigned _sp = 0; while (cond) { __builtin_amdgcn_s_sleep(1); \
    if ((++_sp & 255u) == 0u) { if (xb_ld(&(bar)[XB_TMO])) break; if (_sp > XB_SPIN_CAP) { atomicAdd(&(bar)[XB_TMO], 1u); break; } } } } while (0)

struct XcdBarrier {
    unsigned* bar; unsigned x;
    volatile LAS unsigned* st;
};

__device__ __forceinline__ XcdBarrier xcd_barrier_post(unsigned* bar, volatile LAS unsigned* st) {
    XcdBarrier b; b.bar = bar; b.x = xb_xcc_id(); b.st = st;
    if (threadIdx.x == 0) (void)xb_add(&bar[XB_XCNT(b.x)], 1u);
    return b;
}
__device__ __forceinline__ void xcd_barrier_complete(unsigned* bar, unsigned x, unsigned& nloc, unsigned& nx) {
    const unsigned G = gridDim.x * gridDim.y * gridDim.z;
    unsigned sum, cnt, mine, sp = 0u;
    for (;;) {
        sum = 0u; cnt = 0u; mine = 0u;
#pragma unroll
        for (unsigned j = 0; j < 16; ++j) { const unsigned c = xb_ld(&bar[XB_XCNT(j)]); sum += c; cnt += (c > 0u) ? 1u : 0u; mine = (j == x) ? c : mine; }
        if (sum == G) break;
        __builtin_amdgcn_s_sleep(1);
        if ((++sp & 255u) == 0u) { if (xb_ld(&bar[XB_TMO])) break; if (sp > XB_SPIN_CAP) { atomicAdd(&bar[XB_TMO], 1u); break; } }
    }
    nloc = mine > 0u ? mine : 1u; nx = cnt > 0u ? cnt : 1u;
}

__device__ __forceinline__ void xcd_barrier(const XcdBarrier& b) {
    asm volatile("s_waitcnt vmcnt(0)" ::: "memory");
    __syncthreads();
    if (threadIdx.x == 0) {
        unsigned* bar = b.bar;
        __builtin_amdgcn_s_waitcnt(0);
        unsigned nloc = b.st[0], nx = b.st[1];
        if (nloc == 0u) { xcd_barrier_complete(bar, b.x, nloc, nx); b.st[0] = nloc; b.st[1] = nx; }
        const unsigned old = xb_add(&bar[XB_XSUB(b.x)], 1u);
        const unsigned gen = old / nloc;
        if (old + 1u == (gen + 1u) * nloc) {
            __builtin_amdgcn_fence(__ATOMIC_RELEASE, "agent");
            asm volatile("s_waitcnt vmcnt(0)" ::: "memory");
            const unsigned og = xb_add(&bar[XB_TOP], 1u);
            const unsigned tg = og / nx;
            if (og + 1u == (tg + 1u) * nx) xb_add(&bar[XB_TOPGEN], 1u);
            else XB_SPIN(xb_ld(&bar[XB_TOPGEN]) == tg, bar);
            __builtin_amdgcn_fence(__ATOMIC_ACQUIRE, "agent");
            xb_add(&bar[XB_XGEN(b.x)], 1u);
            asm volatile("s_waitcnt vmcnt(0)" ::: "memory");
        } else {
            XB_SPIN(xb_ld(&bar[XB_XGEN(b.x)]) == gen, bar);
            __builtin_amdgcn_fence(__ATOMIC_ACQUIRE, "agent");
            asm volatile("s_waitcnt vmcnt(0)" ::: "memory");
        }
    }
    __syncthreads();
}
constexpr int NWAVES = 8;
typedef short v4i16_t __attribute__((ext_vector_type(4)));
typedef unsigned u32x2 __attribute__((ext_vector_type(2)));
typedef float f32x2v __attribute__((ext_vector_type(2)));
typedef __bf16 bf16x2_t __attribute__((ext_vector_type(2)));
typedef unsigned u32x4 __attribute__((ext_vector_type(4)));
__device__ __forceinline__ unsigned cvtpk(float lo, float hi) { f32x2v v = {lo, hi}; bf16x2_t b = __builtin_convertvector(v, bf16x2_t); return __builtin_bit_cast(unsigned, b); }
__device__ __forceinline__ float bf2f(unsigned short u) { return __uint_as_float((unsigned)u << 16); }
__device__ __forceinline__ unsigned short f2bf16(float f) { return (unsigned short)(cvtpk(f, 0.f) & 0xffffu); }
__device__ __forceinline__ v4i16_t ldtr(LAS unsigned char* p) { return __builtin_amdgcn_ds_read_tr16_b64_v4i16((LAS v4i16_t*)p); }
__device__ __forceinline__ bf16x8 cat8(v4i16_t a, v4i16_t b) { return (bf16x8){a[0], a[1], a[2], a[3], b[0], b[1], b[2], b[3]}; }
__device__ __forceinline__ bf16x8 pack8(f32x4 a, f32x4 b) { u32x4 w; w.x = cvtpk(a[0], a[1]); w.y = cvtpk(a[2], a[3]); w.z = cvtpk(b[0], b[1]); w.w = cvtpk(b[2], b[3]); return __builtin_bit_cast(bf16x8, w); }
#define MFMA16(a, b, c) __builtin_amdgcn_mfma_f32_16x16x32_bf16((a), (b), (c), 0, 0, 0)

struct Frame {
    LAS unsigned char* lds;
    volatile LAS unsigned* MISC;
    unsigned char* ws;
    int tid, lane, wave, G;
    const float *xp, *xs, *g1, *w_in, *upf, *bf_, *upb, *bb, *gng, *w_out, *g2, *w_gate, *w_up, *w_down, *gfin;
    float* out;
};
__device__ __forceinline__ float wave_sum(float v) {
#pragma unroll
    for (int o = 1; o < 64; o <<= 1) v += __shfl_xor(v, o);
    return v;
}

template <class RowMap>
__device__ __forceinline__ void p0_transpose_item(const float* W, int K, int N, bf16* WT, const float* kscale, LAS float* scr, int item, int lane, RowMap rowmap) {
    const int nblk = N / 32, kb = item / nblk, nb = item % nblk, k0 = 64 * kb, n0 = 32 * nb;
#pragma unroll 8
    for (int i = 0; i < 32; ++i) { const int kk = 2 * i + (lane >> 5); float v = W[(size_t)(k0 + kk) * N + n0 + (lane & 31)]; if (kscale) v *= kscale[k0 + kk]; scr[kk * 33 + (lane & 31)] = v; }
    LDS_WAIT(); asm volatile("" ::: "memory");
    const int c = lane & 7;
#pragma unroll
    for (int j = 0; j < 4; ++j) { const int n = (lane >> 3) + 8 * j; const LAS float* s = scr + (8 * c) * 33 + n;
        v4u o; o.x = pk2(s[0 * 33], s[1 * 33]); o.y = pk2(s[2 * 33], s[3 * 33]); o.z = pk2(s[4 * 33], s[5 * 33]); o.w = pk2(s[6 * 33], s[7 * 33]);
        *(GAS v4u*)(WT + (size_t)rowmap(n0 + n) * K + k0 + 8 * c) = o; }
    LDS_WAIT(); asm volatile("" ::: "memory");
}
struct RowIn { __device__ __forceinline__ int operator()(int n) const {
    if (n >= 1024) return n;
    const int d = n & 63, nn = d >> 5, dd = d & 31;
    return (n & ~63) + 32 * (dd >> 4) + 8 * ((dd >> 2) & 3) + 4 * nn + (dd & 3); } };
struct RowId { __device__ __forceinline__ int operator()(int n) const { return n; } };
struct RowGU { int off; __device__ __forceinline__ int operator()(int n) const { return 256 * (n >> 7) + off + (n & 127); } };

__device__ __forceinline__ void p0_prologue(Frame& F) {
    LAS float* scr = (LAS float*)(F.lds + F.wave * 16384);
    const int gw = blockIdx.x * NWAVES + F.wave, NGW = F.G * NWAVES;
    bf16* Win = (bf16*)(F.ws + WS_WIN); bf16* Wout = (bf16*)(F.ws + WS_WOUT); bf16* Wgu = (bf16*)(F.ws + WS_WGU); bf16* Wdn = (bf16*)(F.ws + WS_WDN);
    constexpr int I_IN = 16 * (NIN / 32), I_OUT = 16 * 32, I_G = 16 * (DFF / 32), I_D = (DFF / 64) * 32;
    constexpr int NITEMS = I_IN + I_OUT + 2 * I_G + I_D;
    for (int it = gw; it < NITEMS; it += NGW) {
        int r = it;
        if (r < I_IN) { p0_transpose_item(F.w_in, DM, NIN, Win, nullptr, scr, r, F.lane, RowIn{}); continue; } r -= I_IN;
        if (r < I_OUT) { p0_transpose_item(F.w_out, DM, DM, Wout, nullptr, scr, r, F.lane, RowId{}); continue; } r -= I_OUT;
        if (r < I_G) { p0_transpose_item(F.w_gate, DM, DFF, Wgu, F.g2, scr, r, F.lane, RowGU{0}); continue; } r -= I_G;
        if (r < I_G) { p0_transpose_item(F.w_up, DM, DFF, Wgu, F.g2, scr, r, F.lane, RowGU{128}); continue; } r -= I_G;
        p0_transpose_item(F.w_down, DFF, DM, Wdn, nullptr, scr, r, F.lane, RowId{});
    }
    { const int gt = blockIdx.x * 512 + F.tid, NT = F.G * 512; v4u z = {0u, 0u, 0u, 0u};
      for (int i = gt; i < (NINP - NIN) * DM / 8; i += NT) *(GAS v4u*)(Win + (size_t)NIN * DM + (size_t)i * 8) = z; }
    { const int gt = blockIdx.x * 512 + F.tid, NT = F.G * 512; float* rc = (float*)(F.ws + WS_ROPE); float* rs = rc + 8192 * 32;
      for (int i = gt; i < 8192 * 32; i += NT) { const int s = i >> 5, f = i & 31;
          const float inv = (float)pow(10000.0, -(double)f / 32.0); const float ang = (float)s * inv;
          rc[i] = (float)cos((double)ang); rs[i] = (float)sin((double)ang); } }
    { bf16* HN = (bf16*)(F.ws + WS_HN);
      f32x4 gv[4];
#pragma unroll
      for (int j = 0; j < 4; ++j) gv[j] = ((const GAS f32x4*)F.g1)[F.lane + 64 * j];
      for (int m = gw; m < MT; m += NGW) {
          const float* xrow = m < MP ? F.xp + (size_t)m * DM : F.xs + (size_t)(m - MP) * DM;
          const GAS f32x4* xr = (const GAS f32x4*)xrow + F.lane;
          f32x4 v[4]; float s = 0.f;
#pragma unroll
          for (int j = 0; j < 4; ++j) { v[j] = xr[64 * j]; s += (v[j].x * v[j].x + v[j].y * v[j].y) + (v[j].z * v[j].z + v[j].w * v[j].w); }
          const float r = 1.0f / sqrtf(wave_sum(s) * (1.0f / DM) + EPS);
          GAS unsigned long long* o8 = (GAS unsigned long long*)(HN + (size_t)m * DM) + F.lane;
#pragma unroll
          for (int j = 0; j < 4; ++j) { const f32x4 y = v[j] * r * gv[j]; o8[64 * j] = (unsigned long long)cvtpk(y.x, y.y) | ((unsigned long long)cvtpk(y.z, y.w) << 32); }
      } }
}

__device__ __forceinline__ void p8_final(Frame& F) {
    const int gw = blockIdx.x * NWAVES + F.wave, NGW = F.G * NWAVES;
    const float* ss = (const float*)(F.ws + WS_SS2);
    f32x4 gv[4];
#pragma unroll
    for (int j = 0; j < 4; ++j) gv[j] = ((const GAS f32x4*)F.gfin)[F.lane + 64 * j];
    for (int m = gw; m < MT; m += NGW) {
        GAS f32x4* xr = (GAS f32x4*)(F.out + (size_t)m * DM) + F.lane;
        const float r = 1.0f / sqrtf(__hip_atomic_load(ss + m, __ATOMIC_RELAXED, __HIP_MEMORY_SCOPE_AGENT) * (1.0f / DM) + EPS);
#pragma unroll
        for (int j = 0; j < 4; ++j) { const f32x4 v = xr[64 * j]; xr[64 * j] = v * r * gv[j]; }
    }
}
__device__ __forceinline__ void attn_phase(Frame& F) {
    const int lane = F.lane, wave = F.wave, lq = lane & 15, g = lane >> 4, tq = (lane & 15) >> 2, tp = lane & 3;
    LAS unsigned char* vbuf = F.lds + wave * 5120;
    const bf16* MIX = (const bf16*)(F.ws + WS_MIX); bf16* MIXW = (bf16*)(F.ws + WS_MIX);
    const bf16* KA = (const bf16*)(F.ws + WS_KA); const bf16* VA = (const bf16*)(F.ws + WS_VA);
    float* scr = (float*)(F.ws + WS_ATT) + (size_t)blockIdx.x * ATT_SCR_FLOATS;
    for (int item = blockIdx.x; item < (MT / 512) * 8; item += F.G) {
        const int cc = item >> 3, h = item & 7, tok0 = cc * 512;
        const int S = tok0 < MP ? 4096 : 8192, seq_base = tok0 & ~(S - 1), c = (tok0 - seq_base) >> 9;
#pragma unroll 1
        for (int pi = 0; pi < 3; ++pi) {
            const int log2d = pi == 0 ? 4 : (pi == 1 ? 2 : 0);
            const int L = S >> log2d, Mres = 512 >> log2d, lg = 4 - log2d;
#pragma unroll 1
            for (int i = 0; i < 2; ++i) {
                const int sb = 2 * wave + i, r = sb >> lg, m0 = Mres * c + 32 * (sb & ((1 << lg) - 1));
                int qrow[2];
#pragma unroll
                for (int qb = 0; qb < 2; ++qb) qrow[qb] = seq_base + ((m0 + 16 * qb + lq) << log2d) + r;
                bf16x8 bq[2][2];
#pragma unroll
                for (int qb = 0; qb < 2; ++qb)
#pragma unroll
                    for (int st = 0; st < 2; ++st) bq[qb][st] = *(const bf16x8*)(MIX + (size_t)qrow[qb] * 1024 + h * 64 + 32 * st + 8 * g);
                f32x4 O[4][2]; float mrun[2], lrun[2];
                if (pi == 0) {
#pragma unroll
                    for (int qb = 0; qb < 2; ++qb) { mrun[qb] = -1e30f; lrun[qb] = 0.f;
#pragma unroll
                        for (int db = 0; db < 4; ++db) O[db][qb] = (f32x4){0.f, 0.f, 0.f, 0.f}; }
                } else {
#pragma unroll
                    for (int qb = 0; qb < 2; ++qb) { const int ti = qrow[qb] - tok0;
#pragma unroll
                        for (int db = 0; db < 4; ++db) O[db][qb] = *(const f32x4*)(scr + ti * 64 + 16 * db + 4 * g);
                        mrun[qb] = scr[32768 + ti]; const float lt = scr[32768 + 512 + ti]; lrun[qb] = g == 0 ? lt : 0.f; }
                }
#pragma unroll 1
                for (int tt = 0; tt < 5; ++tt) {
                    const int t = tt == 0 ? 2 : (tt == 1 ? 1 : (tt == 2 ? 3 : (tt == 3 ? 0 : 4)));
                    const int mk0 = m0 - 64 + 32 * t;
                    if (mk0 < 0 || mk0 >= L) continue;
                    bf16x8 ak[2][2];
#pragma unroll
                    for (int kb = 0; kb < 2; ++kb) { const size_t krow = (size_t)(seq_base + ((mk0 + 16 * kb + lq) << log2d) + r);
#pragma unroll
                        for (int st = 0; st < 2; ++st) ak[kb][st] = *(const bf16x8*)(KA + krow * 512 + h * 64 + 32 * st + 8 * g); }
                    u32x4 vv[4];
#pragma unroll
                    for (int i4 = 0; i4 < 4; ++i4) { const int row = (lane >> 3) + 8 * i4; vv[i4] = *(const u32x4*)(VA + (size_t)(seq_base + ((mk0 + row) << log2d) + r) * 512 + h * 64 + 8 * (lane & 7)); }
#pragma unroll
                    for (int i4 = 0; i4 < 4; ++i4) { const int row = (lane >> 3) + 8 * i4; *(LAS u32x4*)(vbuf + row * 160 + (lane & 7) * 16) = vv[i4]; }
                    f32x4 s[2][2];
#pragma unroll
                    for (int kb = 0; kb < 2; ++kb)
#pragma unroll
                        for (int qb = 0; qb < 2; ++qb) { s[kb][qb] = MFMA16(ak[kb][0], bq[qb][0], ((f32x4){0.f, 0.f, 0.f, 0.f})); s[kb][qb] = MFMA16(ak[kb][1], bq[qb][1], s[kb][qb]); }
                    if (t == 0 || t == 4) {
#pragma unroll
                        for (int kb = 0; kb < 2; ++kb)
#pragma unroll
                            for (int qb = 0; qb < 2; ++qb)
#pragma unroll
                                for (int e = 0; e < 4; ++e) { const int kvi = 16 * kb + 4 * g + e, qi = 16 * qb + lq; const bool dead = (t == 0) ? (kvi < qi) : (kvi > qi); if (dead) s[kb][qb][e] = -1e30f; }
                    }
                    bf16x8 pb[2];
#pragma unroll
                    for (int qb = 0; qb < 2; ++qb) {
                        float mx = fmaxf(fmaxf(fmaxf(s[0][qb][0], s[0][qb][1]), fmaxf(s[0][qb][2], s[0][qb][3])), fmaxf(fmaxf(s[1][qb][0], s[1][qb][1]), fmaxf(s[1][qb][2], s[1][qb][3])));
                        mx = fmaxf(mx, __shfl_xor(mx, 16)); mx = fmaxf(mx, __shfl_xor(mx, 32));
                        const float mn = fmaxf(mrun[qb], mx), alpha = __builtin_amdgcn_exp2f(mrun[qb] - mn); mrun[qb] = mn;
                        f32x4 p0, p1;
#pragma unroll
                        for (int e = 0; e < 4; ++e) { p0[e] = __builtin_amdgcn_exp2f(s[0][qb][e] - mn); p1[e] = __builtin_amdgcn_exp2f(s[1][qb][e] - mn); }
                        lrun[qb] = lrun[qb] * alpha + ((p0[0] + p0[1]) + (p0[2] + p0[3])) + ((p1[0] + p1[1]) + (p1[2] + p1[3]));
#pragma unroll
                        for (int db = 0; db < 4; ++db) O[db][qb] = O[db][qb] * alpha;
                        pb[qb] = pack8(p0, p1);
                    }
#pragma unroll
                    for (int db = 0; db < 4; ++db) {
                        const bf16x8 av = cat8(ldtr(vbuf + (4 * g + tq) * 160 + (16 * db + 4 * tp) * 2), ldtr(vbuf + (16 + 4 * g + tq) * 160 + (16 * db + 4 * tp) * 2));
#pragma unroll
                        for (int qb = 0; qb < 2; ++qb) O[db][qb] = MFMA16(av, pb[qb], O[db][qb]);
                    }
                }
#pragma unroll
                for (int qb = 0; qb < 2; ++qb) {
                    float lt = lrun[qb]; lt += __shfl_xor(lt, 16); lt += __shfl_xor(lt, 32);
                    if (pi < 2) { const int ti = qrow[qb] - tok0;
#pragma unroll
                        for (int db = 0; db < 4; ++db) *(f32x4*)(scr + ti * 64 + 16 * db + 4 * g) = O[db][qb];
                        if (g == 0) { scr[32768 + ti] = mrun[qb]; scr[32768 + 512 + ti] = lt; }
                    } else { const float inv = 1.0f / lt;
#pragma unroll
                        for (int db = 0; db < 4; ++db) { const f32x4 o = O[db][qb] * inv; u32x2 w; w.x = cvtpk(o[0], o[1]); w.y = cvtpk(o[2], o[3]);
                            *(u32x2*)(MIXW + (size_t)qrow[qb] * 1024 + h * 64 + 16 * db + 4 * g) = w; }
                    }
                }
            }
            __syncthreads();
        }
    }
}
__device__ __forceinline__ void gla_load_v(Frame& F, int row0) {
    const bf16* VG = (const bf16*)(F.ws + WS_VG);
#pragma unroll
    for (int i = 0; i < 8; ++i) { const int s = F.wave + 8 * i;
        const u32x4 v = *(const u32x4*)(VG + (size_t)(row0 + s) * 512 + 8 * F.lane);
        *(LAS u32x4*)(F.lds + G_VT + (F.lane >> 4) * G_VT_HEAD + s * 288 + (F.lane & 15) * 16) = v; }
}

__device__ __forceinline__ void gla_g1(Frame& F) {
    const int lane = F.lane, wave = F.wave, lq = lane & 15, g = lane >> 4, tq = (lane & 15) >> 2, tp = lane & 3;
    const int h = wave >> 1, dir = wave & 1;
    const bf16* __restrict__ MIX = (const bf16*)(F.ws + WS_MIX);
    bf16* __restrict__ QE = (bf16*)(F.ws + WS_QE) + (size_t)(2 * dir) * QE_STRIDE; bf16* __restrict__ KE = (bf16*)(F.ws + WS_QE) + (size_t)(2 * dir + 1) * QE_STRIDE;
    bf16* KVT = (bf16*)(F.ws + WS_HN); float* DEC = (float*)(F.ws + WS_DECAY);
    const float* RFB = (const float*)(F.ws + WS_RFB);
    const float* up = dir ? F.upb : F.upf; const float* bias = dir ? F.bb : F.bf_;
    float upr[16];
#pragma unroll
    for (int r = 0; r < 16; ++r) upr[r] = up[r * 256 + h * 64 + lane];
    const float bs = bias[h * 64 + lane];
    LAS float* rfl = (LAS float*)(F.lds + G_RF) + dir * 1024;
    LAS unsigned char* kel = F.lds + G_KE + wave * 9216;
    LAS float* cl = (LAS float*)(F.lds + G_CL) + wave * 64;
    LAS unsigned char* vt = F.lds + G_VT + h * G_VT_HEAD;
    for (int ci = blockIdx.x; ci < NCHUNK; ci += F.G) {
        const int row0 = ci * 64;
        gla_load_v(F, row0);
        { const int s = F.tid >> 3, ch = F.tid & 7; const f32x4 v = *(const f32x4*)(RFB + (size_t)(row0 + s) * 32 + 4 * ch);
          *(LAS f32x4*)((LAS float*)(F.lds + G_RF) + (ch >> 2) * 1024 + s * 16 + 4 * (ch & 3)) = v; }
        __syncthreads();
        float cum = 0.f;
#pragma unroll 4
        for (int ss = 0; ss < 64; ++ss) {
            const int s = dir ? 63 - ss : ss;
            const f32x4 r0 = *(LAS f32x4*)(rfl + s * 16), r1 = *(LAS f32x4*)(rfl + s * 16 + 4), r2 = *(LAS f32x4*)(rfl + s * 16 + 8), r3 = *(LAS f32x4*)(rfl + s * 16 + 12);
            float z = bs;
            z += r0[0] * upr[0]; z += r0[1] * upr[1]; z += r0[2] * upr[2]; z += r0[3] * upr[3];
            z += r1[0] * upr[4]; z += r1[1] * upr[5]; z += r1[2] * upr[6]; z += r1[3] * upr[7];
            z += r2[0] * upr[8]; z += r2[1] * upr[9]; z += r2[2] * upr[10]; z += r2[3] * upr[11];
            z += r3[0] * upr[12]; z += r3[1] * upr[13]; z += r3[2] * upr[14]; z += r3[3] * upr[15];
            const float la = (fminf(z, 0.f) - __logf(1.0f + __expf(-fabsf(z)))) * (1.0f / 16.0f);
            cum += la;
            const size_t row = (size_t)(row0 + s);
            const float q = bf2f(MIX[row * 1024 + 512 + h * 64 + lane]), k = bf2f(MIX[row * 1024 + 768 + h * 64 + lane]);
            const float e = __expf(cum), qe = q * e, ke = k / e;
            const unsigned short keb = f2bf16(ke);
            QE[row * 256 + h * 64 + lane] = f2bf16(qe); KE[row * 256 + h * 64 + lane] = keb;
            *(LAS unsigned short*)(kel + lane * 144 + s * 2) = keb;
        }
        cl[lane] = cum;
        const int itemi = (ci * 4 + h) * 2 + dir;
        DEC[(size_t)itemi * 64 + lane] = __expf(cum);
        LDS_WAIT(); asm volatile("" ::: "memory");
        bf16x8 af[4][2];
#pragma unroll
        for (int cb = 0; cb < 4; ++cb)
#pragma unroll
            for (int ks = 0; ks < 2; ++ks) af[cb][ks] = *(LAS bf16x8*)(kel + (16 * cb + lq) * 144 + (32 * ks + 8 * g) * 2);
        f32x4 scl[4];
#pragma unroll
        for (int cb = 0; cb < 4; ++cb) { const f32x4 c4 = *(LAS f32x4*)(cl + 16 * cb + 4 * g); scl[cb] = (f32x4){__expf(c4[0]), __expf(c4[1]), __expf(c4[2]), __expf(c4[3])}; }
#pragma unroll 1
        for (int half = 0; half < 2; ++half) {
            f32x4 acc[4][4];
#pragma unroll
            for (int cb = 0; cb < 4; ++cb)
#pragma unroll
                for (int d = 0; d < 4; ++d) acc[cb][d] = (f32x4){0.f, 0.f, 0.f, 0.f};
#pragma unroll
            for (int d = 0; d < 4; ++d) { const int db = half * 4 + d;
#pragma unroll
                for (int ks = 0; ks < 2; ++ks) {
                    const bf16x8 bv = cat8(ldtr(vt + (32 * ks + 8 * g + tq) * 288 + (16 * db + 4 * tp) * 2), ldtr(vt + (32 * ks + 8 * g + 4 + tq) * 288 + (16 * db + 4 * tp) * 2));
#pragma unroll
                    for (int cb = 0; cb < 4; ++cb) acc[cb][d] = MFMA16(af[cb][ks], bv, acc[cb][d]);
                } }
#pragma unroll
            for (int d = 0; d < 4; ++d) { const int dv = 16 * (half * 4 + d) + lq;
#pragma unroll
                for (int cb = 0; cb < 4; ++cb) { const f32x4 v = acc[cb][d] * scl[cb]; u32x2 w; w.x = cvtpk(v[0], v[1]); w.y = cvtpk(v[2], v[3]);
                    *(u32x2*)(KVT + ((size_t)itemi * 128 + dv) * 64 + 16 * cb + 4 * g) = w; } }
        }
        __syncthreads();
    }
}

__device__ __forceinline__ void gla_g2(Frame& F) {
    const bf16* __restrict__ KVT = (const bf16*)(F.ws + WS_HN); const float* __restrict__ DEC = (const float*)(F.ws + WS_DECAY); bf16* __restrict__ ST = (bf16*)(F.ws + WS_KA);
    for (int it = blockIdx.x; it < 768; it += F.G) {
        int nch, cbase, rem;
        if (it < 256) { nch = 64; cbase = (it >> 6) * 64; rem = it & 63; } else { const int j = it - 256; nch = 128; cbase = 256 + (j >> 6) * 128; rem = j & 63; }
        const int h = rem >> 4, dir = (rem >> 3) & 1, part = rem & 7;
        const int e = part * 512 + F.tid, dv = e >> 5, dk = (e & 31) * 2;
        float s0 = 0.f, s1 = 0.f;
#pragma unroll 4
        for (int n = 0; n < nch; ++n) {
            const int ci = cbase + (dir ? nch - 1 - n : n);
            const size_t itemi = (size_t)(ci * 4 + h) * 2 + dir, off = (itemi * 128 + dv) * 64 + dk;
            const unsigned kv = *(const unsigned*)(KVT + off);
            const f32x2v dc = *(const f32x2v*)(DEC + itemi * 64 + dk);
            *(unsigned*)(ST + off) = cvtpk(s0, s1);
            s0 = s0 * dc.x + bf2f((unsigned short)(kv & 0xffffu)); s1 = s1 * dc.y + bf2f((unsigned short)(kv >> 16));
        }
    }
}

__device__ __forceinline__ void gla_g3(Frame& F) {
    const int lane = F.lane, wave = F.wave, lq = lane & 15, g = lane >> 4, tq = (lane & 15) >> 2, tp = lane & 3;
    const int h = wave >> 1, chalf = wave & 1;
    const bf16* QEb = (const bf16*)(F.ws + WS_QE); const bf16* ST = (const bf16*)(F.ws + WS_KA); const bf16* OG = (const bf16*)(F.ws + WS_OG);
    bf16* MIXW = (bf16*)(F.ws + WS_MIX);
    LAS unsigned char* vt = F.lds + G_VT + h * G_VT_HEAD;
    for (int ci = blockIdx.x; ci < NCHUNK; ci += F.G) {
        const int row0 = ci * 64;
        gla_load_v(F, row0);
        __syncthreads();
        f32x4 O[8][2];
#pragma unroll
        for (int db = 0; db < 8; ++db)
#pragma unroll
            for (int cb = 0; cb < 2; ++cb) O[db][cb] = (f32x4){0.f, 0.f, 0.f, 0.f};
#pragma unroll 1
        for (int dir = 0; dir < 2; ++dir) {
            const bf16* QE = QEb + (size_t)(2 * dir) * QE_STRIDE; const bf16* KE = QE + QE_STRIDE;
            bf16x8 bq[2][2];
#pragma unroll
            for (int cb = 0; cb < 2; ++cb)
#pragma unroll
                for (int st = 0; st < 2; ++st) bq[cb][st] = *(const bf16x8*)(QE + (size_t)(row0 + 32 * chalf + 16 * cb + lq) * 256 + h * 64 + 32 * st + 8 * g);
#pragma unroll
            for (int ks = 0; ks < 2; ++ks) {
                bf16x8 ak[2][2];
#pragma unroll
                for (int sb = 0; sb < 2; ++sb)
#pragma unroll
                    for (int st = 0; st < 2; ++st) ak[sb][st] = *(const bf16x8*)(KE + (size_t)(row0 + 32 * ks + 16 * sb + lq) * 256 + h * 64 + 32 * st + 8 * g);
                bf16x8 pb[2];
#pragma unroll
                for (int cb = 0; cb < 2; ++cb) {
                    f32x4 sa[2];
#pragma unroll
                    for (int sb = 0; sb < 2; ++sb) { sa[sb] = MFMA16(ak[sb][0], bq[cb][0], ((f32x4){0.f, 0.f, 0.f, 0.f})); sa[sb] = MFMA16(ak[sb][1], bq[cb][1], sa[sb]);
#pragma unroll
                        for (int e = 0; e < 4; ++e) { const int s = 32 * ks + 16 * sb + 4 * g + e, c = 32 * chalf + 16 * cb + lq; const bool keep = dir ? (s > c) : (s <= c); if (!keep) sa[sb][e] = 0.f; } }
                    pb[cb] = pack8(sa[0], sa[1]);
                }
#pragma unroll
                for (int db = 0; db < 8; ++db) {
                    const bf16x8 av = cat8(ldtr(vt + (32 * ks + 4 * g + tq) * 288 + (16 * db + 4 * tp) * 2), ldtr(vt + (32 * ks + 16 + 4 * g + tq) * 288 + (16 * db + 4 * tp) * 2));
#pragma unroll
                    for (int cb = 0; cb < 2; ++cb) O[db][cb] = MFMA16(av, pb[cb], O[db][cb]);
                }
            }
            const size_t itemi = (size_t)(ci * 4 + h) * 2 + dir;
#pragma unroll
            for (int db = 0; db < 8; ++db)
#pragma unroll
                for (int st = 0; st < 2; ++st) { const bf16x8 as = *(const bf16x8*)(ST + (itemi * 128 + 16 * db + lq) * 64 + 32 * st + 8 * g);
#pragma unroll
                    for (int cb = 0; cb < 2; ++cb) O[db][cb] = MFMA16(as, bq[cb][st], O[db][cb]); }
        }
#pragma unroll
        for (int cb = 0; cb < 2; ++cb) {
            float q = 0.f;
#pragma unroll
            for (int db = 0; db < 8; ++db) { const f32x4 v = O[db][cb]; q += (v[0] * v[0] + v[1] * v[1]) + (v[2] * v[2] + v[3] * v[3]); }
            q += __shfl_xor(q, 16); q += __shfl_xor(q, 32);
            const float rinv = 1.0f / sqrtf(q * (1.0f / 128.0f) + EPS);
            const size_t row = (size_t)(row0 + 32 * chalf + 16 * cb + lq);
#pragma unroll
            for (int db = 0; db < 8; ++db) { const int dv = 16 * db + 4 * g;
                const f32x4 gn = *(const f32x4*)(F.gng + h * 128 + dv);
                const u32x2 ogw = *(const u32x2*)(OG + row * 512 + h * 128 + dv);
                const f32x4 og = {bf2f((unsigned short)(ogw.x & 0xffffu)), bf2f((unsigned short)(ogw.x >> 16)), bf2f((unsigned short)(ogw.y & 0xffffu)), bf2f((unsigned short)(ogw.y >> 16))};
                const f32x4 o = O[db][cb] * rinv * gn * og; u32x2 w; w.x = cvtpk(o[0], o[1]); w.y = cvtpk(o[2], o[3]);
                *(u32x2*)(MIXW + row * 1024 + 512 + h * 128 + dv) = w; }
        }
        __syncthreads();
    }
}
constexpr int N_PHASES = 9;
struct Args { const float* in[15]; float* out; unsigned char* ws; int ph_lo, ph_hi; };
static_assert(sizeof(Args) == 17 * 8 + 8, "Args has no padding");

__global__ void __launch_bounds__(NWAVES * 64, 2) fwd_kernel(Args args) {
    extern __shared__ __attribute__((aligned(16))) unsigned char lds[];
    Frame F;
    F.lds = (LAS unsigned char*)lds;
    F.MISC = (volatile LAS unsigned*)(F.lds + MISC_OFF);
    F.tid = threadIdx.x; F.lane = F.tid & 63; F.wave = __builtin_amdgcn_readfirstlane(F.tid >> 6);
    F.G = gridDim.x; F.ws = args.ws; F.out = args.out;
    F.xp = args.in[0]; F.xs = args.in[1]; F.g1 = args.in[2]; F.w_in = args.in[3]; F.upf = args.in[4]; F.bf_ = args.in[5]; F.upb = args.in[6]; F.bb = args.in[7];
    F.gng = args.in[8]; F.w_out = args.in[9]; F.g2 = args.in[10]; F.w_gate = args.in[11]; F.w_up = args.in[12]; F.w_down = args.in[13]; F.gfin = args.in[14];
    for (int u = F.tid; u < 64; u += NWAVES * 64) F.MISC[u] = 0u;
    __syncthreads();
    const int lo = args.ph_lo, hi = args.ph_hi;
    gu32* ctl = (gu32*)(F.ws + WS_CTL);
    XcdBarrier bar; bar.bar = (unsigned*)(ctl + CW_BAR); bar.x = 0; bar.st = nullptr;
    if (hi - lo > 1) bar = xcd_barrier_post((unsigned*)(ctl + CW_BAR), F.MISC + 8);
#define IN(k) (lo <= (k) && (k) < hi)
#define SEAM(k) do { if (IN(k) && IN((k) + 1)) xcd_barrier(bar); } while (0)

    if (IN(0)) { p0_prologue(F); } SEAM(0);

    if (IN(1)) {
        pg8::Gemm g{(const pg8::bf16_t*)(F.ws + WS_HN), (const pg8::bf16_t*)(F.ws + WS_WIN), MT, NINP, DM}; pg8::StaticOrder S; S.init(MT, NINP, F.G, (int)blockIdx.x);
        pg8::EpiInProj E{(pg8::bf16_t*)(F.ws + WS_MIX), (pg8::bf16_t*)(F.ws + WS_KA), (pg8::bf16_t*)(F.ws + WS_VA), (pg8::bf16_t*)(F.ws + WS_VG), (pg8::bf16_t*)(F.ws + WS_OG),
                         (float*)(F.ws + WS_RFB), (const float*)(F.ws + WS_ROPE), (const float*)(F.ws + WS_ROPE) + 8192 * 32};
        pg8::gemm_phase<pg8::EpiInProj, pg8::StaticOrder, true, true>(F.lds, g, S, E);
    } SEAM(1);

    if (IN(2)) { attn_phase(F); gla_g1(F); } SEAM(2);
    if (IN(3)) { gla_g2(F); } SEAM(3);
    if (IN(4)) { gla_g3(F); } SEAM(4);

    if (IN(5)) {
        pg8::Gemm g{(const pg8::bf16_t*)(F.ws + WS_MIX), (const pg8::bf16_t*)(F.ws + WS_WOUT), MT, DM, DM}; pg8::StaticOrder S; S.init(MT, DM, F.G, (int)blockIdx.x);
        pg8::EpiOutProj E{F.xp, F.xs, F.out, (pg8::bf16_t*)(F.ws + WS_HN), (float*)(F.ws + WS_SS1)};
        pg8::gemm_phase<pg8::EpiOutProj, pg8::StaticOrder, true, true>(F.lds, g, S, E);
    } SEAM(5);

    if (IN(6)) {
        pg8::Gemm g{(const pg8::bf16_t*)(F.ws + WS_HN), (const pg8::bf16_t*)(F.ws + WS_WGU), MT, 2 * DFF, DM}; pg8::StaticOrder S; S.init(MT, 2 * DFF, F.G, (int)blockIdx.x);
        pg8::EpiFfn1 E{(pg8::bf16_t*)(F.ws + WS_H), (const float*)(F.ws + WS_SS1)};
        pg8::gemm_phase<pg8::EpiFfn1, pg8::StaticOrder, true, true>(F.lds, g, S, E);
    } SEAM(6);

    if (IN(7)) {
        pg8::Gemm g{(const pg8::bf16_t*)(F.ws + WS_H), (const pg8::bf16_t*)(F.ws + WS_WDN), MT, DM, DFF}; pg8::StaticOrder S; S.init(MT, DM, F.G, (int)blockIdx.x);
        pg8::EpiFfn2 E{F.out, (float*)(F.ws + WS_SS2)};
        pg8::gemm_phase<pg8::EpiFfn2, pg8::StaticOrder, true, true>(F.lds, g, S, E);
    } SEAM(7);

    if (IN(8)) { p8_final(F); }
#undef IN
#undef SEAM
}

extern "C" void kernel_launch(void* const* d_in, const int* in_sizes, int n_in, void* d_out, int out_size, void* d_ws, size_t ws_size, hipStream_t stream) {
    static int grid = 0;
    if (grid == 0) {
        if (n_in != 15 || in_sizes[0] != MP * DM || in_sizes[1] != MS * DM || out_size != MT * DM || ws_size < WS_END) {
            fprintf(stderr, "kernel_launch: unexpected shapes (n_in %d, in0 %d, in1 %d, out %d, ws %zu); nothing launched\n", n_in, n_in > 0 ? in_sizes[0] : -1, n_in > 1 ? in_sizes[1] : -1, out_size, ws_size); grid = -1; return; }
        int dev = 0, cus = 0, per_cu = 0;
        if (hipGetDevice(&dev) != hipSuccess || hipDeviceGetAttribute(&cus, hipDeviceAttributeMultiprocessorCount, dev) != hipSuccess) { grid = -1; return; }
        if (hipFuncSetAttribute((const void*)fwd_kernel, hipFuncAttributeMaxDynamicSharedMemorySize, LDS_BYTES) != hipSuccess) { fprintf(stderr, "kernel_launch: hipFuncSetAttribute failed\n"); grid = -1; return; }
        if (hipOccupancyMaxActiveBlocksPerMultiprocessor(&per_cu, (const void*)fwd_kernel, NWAVES * 64, LDS_BYTES) != hipSuccess || per_cu < 1) { fprintf(stderr, "kernel_launch: occupancy query says %d blocks per CU\n", per_cu); per_cu = 1; }
        (void)hipGetLastError();
        grid = cus * 1;
        if (grid > 256) grid = 256;
    }
    if (grid < 0) return;
    (void)hipMemsetAsync((char*)d_ws + WS_CTL, 0, CTL_ZERO_BYTES, stream);
    Args a{};
    for (int i = 0; i < 15; ++i) a.in[i] = (const float*)d_in[i];
    a.out = (float*)d_out; a.ws = (unsigned char*)d_ws;
#if MK_N_LAUNCHES == 1
    a.ph_lo = 0; a.ph_hi = N_PHASES;
    void* kargs[] = {&a};
    hipError_t e = hipLaunchCooperativeKernel((const void*)fwd_kernel, dim3(grid), dim3(NWAVES * 64), kargs, LDS_BYTES, stream);
    if (e != hipSuccess) fprintf(stderr, "kernel_launch: cooperative launch failed: %s (grid %d)\n", hipGetErrorString(e), grid);
#else
    for (int p = 0; p < N_PHASES; ++p) { a.ph_lo = p; a.ph_hi = p + 1; hipLaunchKernelGGL(fwd_kernel, dim3(grid), dim3(NWAVES * 64), LDS_BYTES, stream, a); }
#endif
}
```

```cpp
#include <hip/hip_runtime.h>
#include <hip/hip_bf16.h>
#include <cstdio>
#include <cstdint>
#include <cmath>

#ifndef MK_N_LAUNCHES
#define MK_N_LAUNCHES 1
#endif

constexpr int DM = 1024;
constexpr int MP = 4 * 4096;
constexpr int MS = 8 * 8192;
constexpr int MT = MP + MS;
constexpr int NIN = 3104, NINP = 3328;
constexpr int DFF = 2816;
constexpr int NCHUNK = MT / 64;
constexpr float EPS = 1e-6f;
constexpr float QSCALE = 0.125f * 1.4426950408889634f;

constexpr size_t MiB = 1u << 20;
constexpr size_t WS_CTL = 0, CTL_ZERO_BYTES = 64 * 1024;
constexpr size_t WS_SS1 = 128 * 1024, WS_SS2 = 512 * 1024;
constexpr size_t WS_WIN = 1 * MiB;
constexpr size_t WS_WOUT = 8 * MiB;
constexpr size_t WS_WGU = 10 * MiB;
constexpr size_t WS_WDN = 21 * MiB;
constexpr size_t WS_ROPE = 27 * MiB;
constexpr size_t WS_DECAY = 29 * MiB;
constexpr size_t WS_R0 = 31 * MiB + 512 * 1024;
constexpr size_t WS_MIX = 32 * MiB;
constexpr size_t WS_HN = 192 * MiB;
constexpr size_t WS_KA = 352 * MiB, WS_VA = 432 * MiB;
constexpr size_t WS_VG = 512 * MiB, WS_OG = 592 * MiB;
constexpr size_t WS_QE = 672 * MiB;
constexpr size_t WS_RFB = 832 * MiB;
constexpr size_t WS_KVT = 848 * MiB;
constexpr size_t WS_H = 352 * MiB;
constexpr size_t WS_END = 1008 * MiB;
constexpr size_t QE_STRIDE = (size_t)MT * 256;
static_assert(WS_H + (size_t)MT * DFF * 2 <= WS_RFB && WS_RFB + (size_t)MT * 32 * 4 <= WS_KVT && WS_KVT + (size_t)NCHUNK * 8 * 8192 * 2 <= WS_END, "ws map");
constexpr int CW_MEET = 1024;
constexpr int TEAM_WGS = 160;
constexpr int CW_TEAM = 2048, CW_AQ = 2112, CW_GQ = 2144;
constexpr int CW_BAR = 4096;

constexpr int LDS_BYTES = 163840;
constexpr int MISC_OFF = LDS_BYTES - 256;
constexpr int G_VT = 0, G_VT_HEAD = 64 * 288;
constexpr int G_KE = 4 * G_VT_HEAD;
constexpr int G_RF = G_KE + 8 * 9216;
constexpr int G_CL = G_RF + 8192;
static_assert(8 * G_VT_HEAD <= MISC_OFF, "lds map");
namespace pg8 {
#define PG8_LAS __attribute__((address_space(3)))
typedef unsigned short bf16_t;
typedef short bf16x8 __attribute__((ext_vector_type(8)));
typedef float f32x4 __attribute__((ext_vector_type(4)));
typedef unsigned u32x4 __attribute__((ext_vector_type(4)));
constexpr int BM = 256, BK = 64, HALF = 128, HTB = HALF * BK * 2  , STAGE_BYTES = 8 * HTB, NXCD = 8, WGM = 8;

__host__ __device__ __forceinline__ int lds_byte(int r, int c) { const int st = (r >> 4) * 2 + (c >> 5), rr = r & 15, cc = c & 31, ob = rr * 64 + cc * 2; return st * 1024 + (ob ^ (((ob >> 9) & 1) << 5)); }
__host__ __device__ __forceinline__ void stage_rc(int b, int& R, int& C) { const int st = b / 1024, sb = b % 1024, swz = sb ^ (((sb >> 9) & 1) << 5); R = (st >> 1) * 16 + swz / 64; C = (st & 1) * 32 + (swz % 64) / 2; }
__host__ __device__ __forceinline__ int perm32(int rho) { const int n = rho >> 4, i = rho & 15; return 8 * (i >> 2) + 4 * n + (i & 3); }

struct Unit { int pm, pn; };
struct Gemm { const bf16_t* A; const bf16_t* Bt; int M, N, K; };

struct StaticOrder {
    int nM, nN, nwg, G, c;
    __host__ __device__ void init(int M, int N, int G_, int c_) { nM = M / BM; nN = N / BM; nwg = nM * nN; G = G_; c = c_; }
    __host__ __device__ bool next(int i, Unit& u) const {
        const long L = (long)i * G + c; if (L >= nwg) return false;
        int wgid = (int)L; { const int q = nwg / NXCD, r = nwg % NXCD, xcd = wgid % NXCD, off = wgid / NXCD; wgid = (xcd < r ? xcd * (q + 1) : r * (q + 1) + (xcd - r) * q) + off; }
        const int nig = WGM * nN, gid = wgid / nig, fm = gid * WGM, gsz = (nM - fm) < WGM ? (nM - fm) : WGM;
        u.pm = fm + ((wgid % nig) % gsz); u.pn = (wgid % nig) / gsz; return true;
    }
    __device__ __forceinline__ void a_ready(const Unit&) const {}
    __device__ __forceinline__ void done(const Unit&) const {}
};

__device__ __forceinline__ unsigned cvt_pk_bf16(float lo, float hi) { unsigned r; asm volatile("v_cvt_pk_bf16_f32 %0, %1, %2" : "=v"(r) : "v"(lo), "v"(hi)); return r; }
typedef float f32x2 __attribute__((ext_vector_type(2)));
typedef unsigned u32x2 __attribute__((ext_vector_type(2)));
__device__ __forceinline__ float silu_f(float x) { return x * __builtin_amdgcn_rcpf(1.0f + __builtin_amdgcn_exp2f(-1.4426950408889634f * x)); }
__device__ __forceinline__ f32x4 silu4(f32x4 x) {
    const f32x4 t = x * (-1.4426950408889634f);
    f32x4 d = {__builtin_amdgcn_exp2f(t[0]), __builtin_amdgcn_exp2f(t[1]), __builtin_amdgcn_exp2f(t[2]), __builtin_amdgcn_exp2f(t[3])}; d = d + 1.0f;
    const f32x4 q = {__builtin_amdgcn_rcpf(d[0]), __builtin_amdgcn_rcpf(d[1]), __builtin_amdgcn_rcpf(d[2]), __builtin_amdgcn_rcpf(d[3])};
    return x * q;
}
__device__ __forceinline__ int seq_pos(int row) { return row < MP ? (row & 4095) : (row & 8191); }

struct EpiInProj {
    struct State { float rr[8]; };
    static constexpr bool PERM = true, AFTER_DRAIN = false, HAS_INIT = true;
    bf16_t* mix; bf16_t* ka; bf16_t* va; bf16_t* vg; bf16_t* og; const float* r0; const float* ropec; const float* ropes;
    __device__ __forceinline__ void init(f32x4 (&acc)[2][2][4][2], State& st, const Unit& u, int wr, int wc, int fr, int fq) const {
        const int row0 = u.pm * BM + wr * 64 + fr;
#pragma unroll
        for (int ai = 0; ai < 2; ++ai)
#pragma unroll
            for (int m = 0; m < 4; ++m) { st.rr[ai * 4 + m] = r0[row0 + ai * HALF + m * 16];
#pragma unroll
                for (int bj = 0; bj < 2; ++bj)
#pragma unroll
                    for (int n = 0; n < 2; ++n) acc[ai][bj][m][n] = (f32x4){0.f, 0.f, 0.f, 0.f}; }
    }
    __device__ __forceinline__ void operator()(const f32x4 (&acc)[2][2][4][2], const State& st, const Unit& u, int wr, int wc, int fr, int fq) const {
        const int pn = u.pn, row0 = u.pm * BM + wr * 64 + fr;
        if (pn < 4) {
            bf16_t* dst; int pitch; float sc;
            if (pn < 2) { dst = mix + pn * 256; pitch = 1024; sc = QSCALE; } else { dst = ka + (pn - 2) * 256; pitch = 512; sc = 1.0f; }
            const int d0 = 16 * (wc & 1) + 4 * fq;
#pragma unroll
            for (int ai = 0; ai < 2; ++ai) {
                f32x4 cs[4], sn[4];
#pragma unroll
                for (int m = 0; m < 4; ++m) { const int s = seq_pos(row0 + ai * HALF + m * 16);
                    cs[m] = *(const f32x4*)(ropec + s * 32 + d0); sn[m] = *(const f32x4*)(ropes + s * 32 + d0); }
#pragma unroll
                for (int m = 0; m < 4; ++m) {
                    const int row = row0 + ai * HALF + m * 16;
#pragma unroll
                    for (int bj = 0; bj < 2; ++bj) {
                        const f32x4 x1 = acc[ai][bj][m][0], x2 = acc[ai][bj][m][1];
                        const float scr = sc * st.rr[ai * 4 + m];
                        const f32x4 o1 = (x1 * cs[m] - x2 * sn[m]) * scr, o2 = (x2 * cs[m] + x1 * sn[m]) * scr;
                        bf16_t* p = dst + (size_t)row * pitch + 64 * (2 * bj + (wc >> 1)) + d0;
                        u32x2 w1, w2; w1.x = cvt_pk_bf16(o1[0], o1[1]); w1.y = cvt_pk_bf16(o1[2], o1[3]); w2.x = cvt_pk_bf16(o2[0], o2[1]); w2.y = cvt_pk_bf16(o2[2], o2[3]);
                        *(u32x2*)p = w1; *(u32x2*)(p + 32) = w2;
                    }
                }
            }
        } else {
            bf16_t* dst; int pitch; float sc = 1.0f; bool act = false;
            if (pn < 6) { dst = va + (pn - 4) * 256; pitch = 512; }
            else if (pn == 6) { dst = mix + 512; pitch = 1024; sc = 0.125f; }
            else if (pn == 7) { dst = mix + 768; pitch = 1024; }
            else if (pn < 10) { dst = vg + (pn - 8) * 256; pitch = 512; }
            else { dst = og + (pn - 10) * 256; pitch = 512; act = true; }
            const int col0 = wc * 32 + 8 * fq;
#pragma unroll
            for (int ai = 0; ai < 2; ++ai)
#pragma unroll
                for (int m = 0; m < 4; ++m) {
                    bf16_t* rowp = dst + (size_t)(row0 + ai * HALF + m * 16) * pitch + col0;
#pragma unroll
                    for (int bj = 0; bj < 2; ++bj) {
                        const float scr = sc * st.rr[ai * 4 + m];
                        f32x4 v0 = acc[ai][bj][m][0] * scr, v1 = acc[ai][bj][m][1] * scr;
                        if (act) { v0 = silu4(v0); v1 = silu4(v1); }
                        u32x4 w; w.x = cvt_pk_bf16(v0[0], v0[1]); w.y = cvt_pk_bf16(v0[2], v0[3]); w.z = cvt_pk_bf16(v1[0], v1[1]); w.w = cvt_pk_bf16(v1[2], v1[3]);
                        *(u32x4*)(rowp + bj * HALF) = w;
                    }
                }
        }
    }
};

struct EpiOutProj {
    struct State {};
    static constexpr bool PERM = true, AFTER_DRAIN = false, HAS_INIT = true;
    bf16_t* x1b; float* ss;
    __device__ __forceinline__ void init(f32x4 (&acc)[2][2][4][2], State& st, const Unit& u, int wr, int wc, int fr, int fq) const {
        const int row0 = u.pm * BM + wr * 64 + fr, col0 = u.pn * BM + wc * 32 + 8 * fq;
#pragma unroll
        for (int ai = 0; ai < 2; ++ai)
#pragma unroll
            for (int m = 0; m < 4; ++m) { const bf16_t* brow = x1b + (size_t)(row0 + ai * HALF + m * 16) * DM + col0;
#pragma unroll
                for (int bj = 0; bj < 2; ++bj) { const u32x4 w = *(const u32x4*)(brow + bj * HALF);
                    acc[ai][bj][m][0] = (f32x4){__uint_as_float(w.x << 16), __uint_as_float(w.x & 0xffff0000u), __uint_as_float(w.y << 16), __uint_as_float(w.y & 0xffff0000u)};
                    acc[ai][bj][m][1] = (f32x4){__uint_as_float(w.z << 16), __uint_as_float(w.z & 0xffff0000u), __uint_as_float(w.w << 16), __uint_as_float(w.w & 0xffff0000u)}; } }
    }
    __device__ __forceinline__ void operator()(const f32x4 (&acc)[2][2][4][2], const State& st, const Unit& u, int wr, int wc, int fr, int fq) const {
        const int row0 = u.pm * BM + wr * 64 + fr, col0 = u.pn * BM + wc * 32 + 8 * fq;
#pragma unroll
        for (int ai = 0; ai < 2; ++ai)
#pragma unroll
            for (int m = 0; m < 4; ++m) {
                const int row = row0 + ai * HALF + m * 16;
                bf16_t* brow = x1b + (size_t)row * DM + col0;
                f32x4 q4 = {0.f, 0.f, 0.f, 0.f};
#pragma unroll
                for (int bj = 0; bj < 2; ++bj) {
                    const f32x4 v0 = acc[ai][bj][m][0], v1 = acc[ai][bj][m][1];
                    u32x4 w; w.x = cvt_pk_bf16(v0[0], v0[1]); w.y = cvt_pk_bf16(v0[2], v0[3]); w.z = cvt_pk_bf16(v1[0], v1[1]); w.w = cvt_pk_bf16(v1[2], v1[3]);
                    *(u32x4*)(brow + bj * HALF) = w;
                    q4 = q4 + v0 * v0 + v1 * v1;
                }
                float q = (q4[0] + q4[1]) + (q4[2] + q4[3]);
                q += __shfl_xor(q, 16); q += __shfl_xor(q, 32);
                if (fq == 0) atomicAdd(ss + row, q);
            }
    }
};

template <int MODE> struct EpiFfn1T {
    struct State { float ssv[8]; };
    static constexpr bool PERM = true, AFTER_DRAIN = false, HAS_INIT = true;
    bf16_t* h; const float* ss;
    __device__ __forceinline__ void init(f32x4 (&acc)[2][2][4][2], State& st, const Unit& u, int wr, int wc, int fr, int fq) const {
        const int row0 = u.pm * BM + wr * 64 + fr;
#pragma unroll
        for (int ai = 0; ai < 2; ++ai)
#pragma unroll
            for (int m = 0; m < 4; ++m) { st.ssv[ai * 4 + m] = __hip_atomic_load(ss + row0 + ai * HALF + m * 16, __ATOMIC_RELAXED, __HIP_MEMORY_SCOPE_AGENT);
#pragma unroll
                for (int bj = 0; bj < 2; ++bj)
#pragma unroll
                    for (int n = 0; n < 2; ++n) acc[ai][bj][m][n] = (f32x4){0.f, 0.f, 0.f, 0.f}; }
    }
    __device__ __forceinline__ void operator()(const f32x4 (&acc)[2][2][4][2], const State& st, const Unit& u, int wr, int wc, int fr, int fq) const {
        const int row0 = u.pm * BM + wr * 64 + fr, col0 = u.pn * HALF + wc * 32 + 8 * fq;
        if (MODE == 1) {
#pragma unroll
            for (int ai = 0; ai < 2; ++ai)
#pragma unroll
                for (int m = 0; m < 4; ++m)
#pragma unroll
                    for (int bj = 0; bj < 2; ++bj)
#pragma unroll
                        for (int n = 0; n < 2; ++n) asm volatile("" :: "v"(acc[ai][bj][m][n]));
            return; }
#pragma unroll
        for (int ai = 0; ai < 2; ++ai)
#pragma unroll
            for (int m = 0; m < 4; ++m) {
                const int row = row0 + ai * HALF + m * 16;
                const float r = __builtin_amdgcn_rsqf(st.ssv[ai * 4 + m] * (1.0f / DM) + EPS);
                const f32x2 r2 = {r, r};
                unsigned wv[4];
#pragma unroll
                for (int n = 0; n < 2; ++n)
#pragma unroll
                    for (int p = 0; p < 2; ++p) {
                        const f32x2 a = (f32x2){acc[ai][0][m][n][2 * p], acc[ai][0][m][n][2 * p + 1]} * r2, b = (f32x2){acc[ai][1][m][n][2 * p], acc[ai][1][m][n][2 * p + 1]} * r2;
                        const f32x2 t = a * (-1.4426950408889634f);
                        f32x2 d; d.x = __builtin_amdgcn_exp2f(t.x); d.y = __builtin_amdgcn_exp2f(t.y); d = d + 1.0f;
                        f32x2 q; q.x = __builtin_amdgcn_rcpf(d.x); q.y = __builtin_amdgcn_rcpf(d.y);
                        const f32x2 o = (a * b) * q;
                        wv[2 * n + p] = cvt_pk_bf16(o.x, o.y);
                    }
                u32x4 w; w.x = wv[0]; w.y = wv[1]; w.z = wv[2]; w.w = wv[3];
                *(u32x4*)(h + (size_t)row * DFF + col0) = w;
            }
    }
};

typedef EpiFfn1T<0> EpiFfn1;

struct EpiFfn2 {
    struct State {};
    static constexpr bool PERM = true, AFTER_DRAIN = false, HAS_INIT = true;
    const bf16_t* x1b; bf16_t* x2b; float* ss;
    __device__ __forceinline__ void init(f32x4 (&acc)[2][2][4][2], State& st, const Unit& u, int wr, int wc, int fr, int fq) const {
        const int row0 = u.pm * BM + wr * 64 + fr, col0 = u.pn * BM + wc * 32 + 8 * fq;
#pragma unroll
        for (int ai = 0; ai < 2; ++ai)
#pragma unroll
            for (int m = 0; m < 4; ++m) { const bf16_t* brow = x1b + (size_t)(row0 + ai * HALF + m * 16) * DM + col0;
#pragma unroll
                for (int bj = 0; bj < 2; ++bj) { const u32x4 w = *(const u32x4*)(brow + bj * HALF);
                    acc[ai][bj][m][0] = (f32x4){__uint_as_float(w.x << 16), __uint_as_float(w.x & 0xffff0000u), __uint_as_float(w.y << 16), __uint_as_float(w.y & 0xffff0000u)};
                    acc[ai][bj][m][1] = (f32x4){__uint_as_float(w.z << 16), __uint_as_float(w.z & 0xffff0000u), __uint_as_float(w.w << 16), __uint_as_float(w.w & 0xffff0000u)}; } }
    }
    __device__ __forceinline__ void operator()(const f32x4 (&acc)[2][2][4][2], const State& st, const Unit& u, int wr, int wc, int fr, int fq) const {
        const int row0 = u.pm * BM + wr * 64 + fr, col0 = u.pn * BM + wc * 32 + 8 * fq;
#pragma unroll
        for (int ai = 0; ai < 2; ++ai)
#pragma unroll
            for (int m = 0; m < 4; ++m) {
                const int row = row0 + ai * HALF + m * 16;
                bf16_t* brow = x2b + (size_t)row * DM + col0;
                f32x4 q4 = {0.f, 0.f, 0.f, 0.f};
#pragma unroll
                for (int bj = 0; bj < 2; ++bj) {
                    const f32x4 v0 = acc[ai][bj][m][0], v1 = acc[ai][bj][m][1];
                    u32x4 w; w.x = cvt_pk_bf16(v0[0], v0[1]); w.y = cvt_pk_bf16(v0[2], v0[3]); w.z = cvt_pk_bf16(v1[0], v1[1]); w.w = cvt_pk_bf16(v1[2], v1[3]);
                    *(u32x4*)(brow + bj * HALF) = w;
                    q4 = q4 + v0 * v0 + v1 * v1;
                }
                float q = (q4[0] + q4[1]) + (q4[2] + q4[3]);
                q += __shfl_xor(q, 16); q += __shfl_xor(q, 32);
                if (fq == 0) atomicAdd(ss + row, q);
            }
    }
};

struct EpiFfn2F {
    struct State {};
    static constexpr bool PERM = true, AFTER_DRAIN = false, HAS_INIT = true;
    const bf16_t* x1b; float* out; float* ss; unsigned* cnt; unsigned* tmo; const float* gf;
    __device__ __forceinline__ void init(f32x4 (&acc)[2][2][4][2], State& st, const Unit& u, int wr, int wc, int fr, int fq) const {
        const int row0 = u.pm * BM + wr * 64 + fr, col0 = u.pn * BM + wc * 32 + 8 * fq;
#pragma unroll
        for (int ai = 0; ai < 2; ++ai)
#pragma unroll
            for (int m = 0; m < 4; ++m) { const bf16_t* brow = x1b + (size_t)(row0 + ai * HALF + m * 16) * DM + col0;
#pragma unroll
                for (int bj = 0; bj < 2; ++bj) { const u32x4 w = *(const u32x4*)(brow + bj * HALF);
                    acc[ai][bj][m][0] = (f32x4){__uint_as_float(w.x << 16), __uint_as_float(w.x & 0xffff0000u), __uint_as_float(w.y << 16), __uint_as_float(w.y & 0xffff0000u)};
                    acc[ai][bj][m][1] = (f32x4){__uint_as_float(w.z << 16), __uint_as_float(w.z & 0xffff0000u), __uint_as_float(w.w << 16), __uint_as_float(w.w & 0xffff0000u)}; } }
    }
    __device__ __forceinline__ void operator()(const f32x4 (&acc)[2][2][4][2], const State& st, const Unit& u, int wr, int wc, int fr, int fq) const {
        const int row0 = u.pm * BM + wr * 64 + fr, col0 = u.pn * BM + wc * 32 + 8 * fq;
#pragma unroll
        for (int ai = 0; ai < 2; ++ai)
#pragma unroll
            for (int m = 0; m < 4; ++m) {
                f32x4 q4 = {0.f, 0.f, 0.f, 0.f};
#pragma unroll
                for (int bj = 0; bj < 2; ++bj) { const f32x4 v0 = acc[ai][bj][m][0], v1 = acc[ai][bj][m][1]; q4 = q4 + v0 * v0 + v1 * v1; }
                float q = (q4[0] + q4[1]) + (q4[2] + q4[3]);
                q += __shfl_xor(q, 16); q += __shfl_xor(q, 32);
                if (fq == 0) (void)__hip_atomic_fetch_add(ss + row0 + ai * HALF + m * 16, q, __ATOMIC_RELAXED, __HIP_MEMORY_SCOPE_AGENT);
            }
        asm volatile("s_waitcnt vmcnt(0)" ::: "memory");
        __syncthreads();
        if (threadIdx.x == 0) {
            (void)__hip_atomic_fetch_add(cnt + u.pm, 1u, __ATOMIC_RELAXED, __HIP_MEMORY_SCOPE_AGENT);
            unsigned sp = 0u;
            while (__hip_atomic_load(cnt + u.pm, __ATOMIC_RELAXED, __HIP_MEMORY_SCOPE_AGENT) < 4u) { __builtin_amdgcn_s_sleep(1);
                if ((++sp & 255u) == 0u) { if (__hip_atomic_load(tmo, __ATOMIC_RELAXED, __HIP_MEMORY_SCOPE_AGENT)) break; if (sp > (1u << 18)) { atomicAdd(tmo, 1u); break; } } }
        }
        __syncthreads();
        f32x4 g4[2][2];
#pragma unroll
        for (int bj = 0; bj < 2; ++bj) { g4[bj][0] = *(const f32x4*)(gf + col0 + bj * HALF); g4[bj][1] = *(const f32x4*)(gf + col0 + bj * HALF + 4); }
        float rr[2][4];
#pragma unroll
        for (int ai = 0; ai < 2; ++ai)
#pragma unroll
            for (int m = 0; m < 4; ++m) rr[ai][m] = __hip_atomic_load(ss + row0 + ai * HALF + m * 16, __ATOMIC_RELAXED, __HIP_MEMORY_SCOPE_AGENT);
#pragma unroll
        for (int ai = 0; ai < 2; ++ai)
#pragma unroll
            for (int m = 0; m < 4; ++m) {
                const float r = 1.0f / sqrtf(rr[ai][m] * (1.0f / DM) + EPS);
                float* orow = out + (size_t)(row0 + ai * HALF + m * 16) * DM + col0;
#pragma unroll
                for (int bj = 0; bj < 2; ++bj) { *(f32x4*)(orow + bj * HALF) = acc[ai][bj][m][0] * r * g4[bj][0]; *(f32x4*)(orow + bj * HALF + 4) = acc[ai][bj][m][1] * r * g4[bj][1]; }
            }
    }
};

template <class Epi, class Sched, bool ALIGN_EPI = false, bool SP2 = false>
__device__ __forceinline__ void gemm_phase(PG8_LAS unsigned char* lds, const Gemm g, const Sched& S, const Epi& E) {
    const int tid = threadIdx.x, wid = __builtin_amdgcn_readfirstlane(tid >> 6), lane = tid & 63, wr = wid >> 2, wc = wid & 3, fr = lane & 15, fq = lane >> 4;
    const int K = g.K, nt = K / BK;
    unsigned voffA[2], voffB[2];
#pragma unroll
    for (int i = 0; i < 2; ++i) { int R, C; stage_rc(tid * 16 + i * 8192, R, C); const int Rb = Epi::PERM ? ((R & ~31) + perm32(R & 31)) : R;
        voffA[i] = (unsigned)(R * K + C) * 2u; voffB[i] = (unsigned)(Rb * K + C) * 2u; }
    const size_t kstep = (size_t)(BK * 2);
    const size_t hstep = (size_t)HALF * K * 2;
    const size_t tstep = 2 * hstep;
    const unsigned ldsw = (unsigned)wid * 1024u;
    const int aoff = lds_byte(wr * 64 + fr, fq * 8), boff = lds_byte(wc * 32 + fr, fq * 8);
#define PG8_SA(b, h) (((b) * 2 + (h)) * HTB)
#define PG8_SB(b, h) ((4 + (b) * 2 + (h)) * HTB)
#define PG8_STAGE(bufoff, gbase, voff) do { _Pragma("unroll") for (int _i = 0; _i < 2; ++_i) \
        __builtin_amdgcn_global_load_lds((const unsigned*)((const char*)(gbase) + (voff)[_i]), (PG8_LAS unsigned*)(lds + (bufoff) + ldsw + _i * 8192), 16, 0, 0); } while (0)
#define PG8_LDA(dst, b, h) do { _Pragma("unroll") for (int m = 0; m < 4; ++m) _Pragma("unroll") for (int k = 0; k < 2; ++k) dst[m][k] = *(const PG8_LAS bf16x8*)(lds + PG8_SA(b, h) + aoff + m * 2048 + k * 1024); } while (0)
#define PG8_LDB(dst, b, h) do { _Pragma("unroll") for (int n = 0; n < 2; ++n) _Pragma("unroll") for (int k = 0; k < 2; ++k) dst[n][k] = *(const PG8_LAS bf16x8*)(lds + PG8_SB(b, h) + boff + n * 2048 + k * 1024); } while (0)
#define PG8_MMA(ai, bj, At, Bt) do { __builtin_amdgcn_s_setprio(1); _Pragma("unroll") for (int m = 0; m < 4; ++m) _Pragma("unroll") for (int n = 0; n < 2; ++n) _Pragma("unroll") for (int k = 0; k < 2; ++k) \
        acc[ai][bj][m][n] = __builtin_amdgcn_mfma_f32_16x16x32_bf16(Bt[n][k], At[m][k], acc[ai][bj][m][n], 0, 0, 0); __builtin_amdgcn_s_setprio(0); } while (0)
#define PG8_WAIT_V(n) asm volatile("s_waitcnt vmcnt(" #n ")" ::: "memory")
#define PG8_WAIT_L(n) asm volatile("s_waitcnt lgkmcnt(" #n ")" ::: "memory")
#define PG8_BAR __builtin_amdgcn_s_barrier()
#define PG8_SCHED __builtin_amdgcn_sched_barrier(0)
    Unit cur, nxt; int ui = 0;
    if (!S.next(0, cur)) return;
    f32x4 acc[2][2][4][2]; typename Epi::State est;
    if constexpr (Epi::HAS_INIT) E.init(acc, est, cur, wr, wc, fr, fq);
    else {
#pragma unroll
    for (int a = 0; a < 2; ++a)
#pragma unroll
        for (int b = 0; b < 2; ++b)
#pragma unroll
            for (int m = 0; m < 4; ++m)
#pragma unroll
                for (int n = 0; n < 2; ++n) acc[a][b][m][n] = (f32x4){0.f, 0.f, 0.f, 0.f};
    }
    bf16x8 At[4][2], B0[2][2], B1[2][2];
    const char* cA = (const char*)g.A + (size_t)cur.pm * tstep; const char* cB = (const char*)g.Bt + (size_t)cur.pn * tstep;
    S.a_ready(cur);
    if constexpr (SP2) {
        PG8_STAGE(PG8_SB(0, 0), cB, voffB); PG8_STAGE(PG8_SB(0, 1), cB + hstep, voffB); PG8_STAGE(PG8_SA(0, 0), cA, voffA); PG8_STAGE(PG8_SA(0, 1), cA + hstep, voffA);
        if (wr == 1) PG8_BAR;
        PG8_WAIT_V(2); PG8_BAR;
        PG8_STAGE(PG8_SB(1, 0), cB + kstep, voffB); PG8_STAGE(PG8_SA(1, 0), cA + kstep, voffA); PG8_STAGE(PG8_SB(1, 1), cB + hstep + kstep, voffB);
        PG8_WAIT_V(6); PG8_BAR;
    } else {
        PG8_STAGE(PG8_SB(0, 0), cB, voffB); PG8_STAGE(PG8_SA(0, 0), cA, voffA); PG8_STAGE(PG8_SB(0, 1), cB + hstep, voffB); PG8_STAGE(PG8_SA(0, 1), cA + hstep, voffA);
        if (wr == 1) PG8_BAR;
        PG8_WAIT_V(4); PG8_BAR;
        PG8_STAGE(PG8_SB(1, 0), cB + kstep, voffB); PG8_STAGE(PG8_SA(1, 0), cA + kstep, voffA); PG8_STAGE(PG8_SB(1, 1), cB + hstep + kstep, voffB);
        PG8_WAIT_V(6); PG8_BAR;
    }
    for (;;) {
        const bool has_next = S.next(ui + 1, nxt);
        const char* nA = has_next ? (const char*)g.A + (size_t)nxt.pm * tstep : cA; const char* nB = has_next ? (const char*)g.Bt + (size_t)nxt.pn * tstep : cB;
        for (int t = 0; t < nt; t += 2) {
            const bool last = (t == nt - 2);
            const char* a1 = cA + (size_t)(t + 1) * kstep;
            const char* a2 = last ? nA : cA + (size_t)(t + 2) * kstep; const char* b2 = last ? nB : cB + (size_t)(t + 2) * kstep;
            const char* a3 = a2 + kstep; const char* b3 = b2 + kstep;
            if (last && has_next) S.a_ready(nxt);
            if constexpr (SP2) {
            PG8_LDB(B0, 0, 0); PG8_LDB(B1, 0, 1); PG8_SCHED; PG8_LDA(At, 0, 0); PG8_STAGE(PG8_SA(1, 1), a1 + hstep, voffA);
            PG8_WAIT_V(8); PG8_WAIT_L(0); PG8_BAR; PG8_MMA(0, 0, At, B0); PG8_MMA(0, 1, At, B1); PG8_BAR; PG8_SCHED;
            PG8_LDA(At, 0, 1); PG8_STAGE(PG8_SB(0, 0), b2, voffB); PG8_STAGE(PG8_SB(0, 1), b2 + hstep, voffB); PG8_STAGE(PG8_SA(0, 0), a2, voffA);
            PG8_WAIT_V(8); PG8_WAIT_L(0); PG8_BAR; PG8_MMA(1, 0, At, B0); PG8_MMA(1, 1, At, B1); PG8_BAR; PG8_SCHED;
            PG8_LDB(B0, 1, 0); PG8_LDB(B1, 1, 1); PG8_SCHED; PG8_LDA(At, 1, 0); PG8_STAGE(PG8_SA(0, 1), a2 + hstep, voffA);
            PG8_WAIT_V(8); PG8_WAIT_L(0); PG8_BAR; PG8_MMA(0, 0, At, B0); PG8_MMA(0, 1, At, B1); PG8_BAR; PG8_SCHED;
            PG8_LDA(At, 1, 1); PG8_STAGE(PG8_SB(1, 0), b3, voffB); PG8_STAGE(PG8_SB(1, 1), b3 + hstep, voffB); PG8_STAGE(PG8_SA(1, 0), a3, voffA);
            PG8_WAIT_V(8); PG8_WAIT_L(0); PG8_BAR; PG8_MMA(1, 0, At, B0); PG8_MMA(1, 1, At, B1); PG8_BAR; PG8_SCHED;
            } else {
            PG8_LDB(B0, 0, 0); PG8_SCHED; PG8_LDA(At, 0, 0); PG8_STAGE(PG8_SA(1, 1), a1 + hstep, voffA);
            PG8_WAIT_L(8); PG8_BAR; PG8_WAIT_L(0); PG8_MMA(0, 0, At, B0); PG8_BAR; PG8_SCHED;
            PG8_LDB(B1, 0, 1); PG8_STAGE(PG8_SB(0, 0), b2, voffB);
            PG8_BAR; PG8_WAIT_L(0); PG8_MMA(0, 1, At, B1); PG8_BAR;
            PG8_LDA(At, 0, 1); PG8_STAGE(PG8_SA(0, 0), a2, voffA);
            PG8_BAR; PG8_WAIT_L(0); PG8_MMA(1, 0, At, B0); PG8_BAR; PG8_SCHED;
            PG8_STAGE(PG8_SB(0, 1), b2 + hstep, voffB);
            PG8_WAIT_V(6); PG8_BAR; PG8_MMA(1, 1, At, B1); PG8_BAR;
            PG8_LDB(B0, 1, 0); PG8_SCHED; PG8_LDA(At, 1, 0); PG8_STAGE(PG8_SA(0, 1), a2 + hstep, voffA);
            PG8_WAIT_L(8); PG8_BAR; PG8_WAIT_L(0); PG8_MMA(0, 0, At, B0); PG8_BAR; PG8_SCHED;
            PG8_LDB(B1, 1, 1); PG8_STAGE(PG8_SB(1, 0), b3, voffB);
            PG8_BAR; PG8_WAIT_L(0); PG8_MMA(0, 1, At, B1); PG8_BAR;
            PG8_LDA(At, 1, 1); PG8_STAGE(PG8_SA(1, 0), a3, voffA);
            PG8_BAR; PG8_WAIT_L(0); PG8_MMA(1, 0, At, B0); PG8_BAR; PG8_SCHED;
            PG8_STAGE(PG8_SB(1, 1), b3 + hstep, voffB);
            PG8_WAIT_V(6); PG8_BAR; PG8_MMA(1, 1, At, B1); PG8_BAR;
            }
        }
        if constexpr (ALIGN_EPI) { if (wr == 0) PG8_BAR; }
        if constexpr (!Epi::AFTER_DRAIN) { E(acc, est, cur, wr, wc, fr, fq); S.done(cur); }
        if (!has_next) break;
        if constexpr (Epi::HAS_INIT) E.init(acc, est, nxt, wr, wc, fr, fq);
        else {
#pragma unroll
        for (int a = 0; a < 2; ++a)
#pragma unroll
            for (int b = 0; b < 2; ++b)
#pragma unroll
                for (int m = 0; m < 4; ++m)
#pragma unroll
                    for (int n = 0; n < 2; ++n) acc[a][b][m][n] = (f32x4){0.f, 0.f, 0.f, 0.f};
        }
        cur = nxt; cA = nA; cB = nB; ++ui;
        if constexpr (ALIGN_EPI) { if (wr == 1) PG8_BAR; }
    }
    PG8_WAIT_V(0);
    if constexpr (!ALIGN_EPI) { if (wr == 0) PG8_BAR; }
    PG8_BAR;
    if constexpr (Epi::AFTER_DRAIN) { E.fused(acc, cur, wr, wc, fr, fq, lds, wid, lane); S.done(cur); }
#undef PG8_SA
#undef PG8_SB
#undef PG8_STAGE
#undef PG8_LDA
#undef PG8_LDB
#undef PG8_MMA
#undef PG8_WAIT_V
#undef PG8_WAIT_L
#undef PG8_BAR
#undef PG8_SCHED
}
}
#define GAS __attribute__((address_space(1)))
#define LAS __attribute__((address_space(3)))
typedef unsigned short bf16;
typedef unsigned v4u __attribute__((ext_vector_type(4)));
typedef float f32x4 __attribute__((ext_vector_type(4)));
typedef short bf16x8 __attribute__((ext_vector_type(8)));
typedef GAS unsigned gu32;
typedef GAS unsigned long long gu64;
#define RLX_AGENT __ATOMIC_RELAXED, __HIP_MEMORY_SCOPE_AGENT
#define LDS_WAIT() asm volatile("s_waitcnt lgkmcnt(0)" ::: "memory")
#define VM_WAIT() asm volatile("s_waitcnt vmcnt(0)" ::: "memory")
__device__ __forceinline__ unsigned long long rt() { return __builtin_amdgcn_s_memrealtime(); }
__device__ __forceinline__ unsigned f2bf(float f) { unsigned u = __builtin_bit_cast(unsigned, f); return (u + 0x7fffu + ((u >> 16) & 1u)) >> 16; }
__device__ __forceinline__ unsigned pk2(float lo, float hi) { return f2bf(lo) | (f2bf(hi) << 16); }

#define XB_TMO      128
#define XB_XCNT(j)  (256  + 64 * (j))
#define XB_XSUB(j)  (1280 + 64 * (j))
#define XB_XGEN(j)  (2304 + 64 * (j))
#define XB_TOP      3328
#define XB_TOPGEN   3392
#define XCD_BAR_WORDS 3456
#define XB_SPIN_CAP (1u << 18)

__device__ __forceinline__ unsigned xb_ld(unsigned* p)              { return __hip_atomic_load(p, __ATOMIC_RELAXED, __HIP_MEMORY_SCOPE_AGENT); }
__device__ __forceinline__ unsigned xb_add(unsigned* p, unsigned v) { return __hip_atomic_fetch_add(p, v, __ATOMIC_RELAXED, __HIP_MEMORY_SCOPE_AGENT); }
__device__ __forceinline__ unsigned xb_xcc_id() { return (unsigned)__builtin_amdgcn_s_getreg((3 << 11) | 20) & 0xFu; }
#define XB_SPIN(cond, bar) do { unsigned _sp = 0; while (cond) { __builtin_amdgcn_s_sleep(1); \
    if ((++_sp & 255u) == 0u) { if (xb_ld(&(bar)[XB_TMO])) break; if (_sp > XB_SPIN_CAP) { atomicAdd(&(bar)[XB_TMO], 1u); break; } } } } while (0)

struct XcdBarrier {
    unsigned* bar; unsigned x;
    volatile LAS unsigned* st;
};

__device__ __forceinline__ XcdBarrier xcd_barrier_post(unsigned* bar, volatile LAS unsigned* st) {
    XcdBarrier b; b.bar = bar; b.x = xb_xcc_id(); b.st = st;
    if (threadIdx.x == 0) (void)xb_add(&bar[XB_XCNT(b.x)], 1u);
    return b;
}
__device__ __forceinline__ void xcd_barrier_complete(unsigned* bar, unsigned x, unsigned& nloc, unsigned& nx) {
    const unsigned G = gridDim.x * gridDim.y * gridDim.z;
    unsigned sum, cnt, mine, sp = 0u;
    for (;;) {
        sum = 0u; cnt = 0u; mine = 0u;
#pragma unroll
        for (unsigned j = 0; j < 16; ++j) { const unsigned c = xb_ld(&bar[XB_XCNT(j)]); sum += c; cnt += (c > 0u) ? 1u : 0u; mine = (j == x) ? c : mine; }
        if (sum == G) break;
        __builtin_amdgcn_s_sleep(1);
        if ((++sp & 255u) == 0u) { if (xb_ld(&bar[XB_TMO])) break; if (sp > XB_SPIN_CAP) { atomicAdd(&bar[XB_TMO], 1u); break; } }
    }
    nloc = mine > 0u ? mine : 1u; nx = cnt > 0u ? cnt : 1u;
}

__device__ __forceinline__ void xcd_barrier(const XcdBarrier& b) {
    asm volatile("s_waitcnt vmcnt(0)" ::: "memory");
    __syncthreads();
    if (threadIdx.x == 0) {
        unsigned* bar = b.bar;
        __builtin_amdgcn_s_waitcnt(0);
        unsigned nloc = b.st[0], nx = b.st[1];
        if (nloc == 0u) { xcd_barrier_complete(bar, b.x, nloc, nx); b.st[0] = nloc; b.st[1] = nx; }
        const unsigned old = xb_add(&bar[XB_XSUB(b.x)], 1u);
        const unsigned gen = old / nloc;
        if (old + 1u == (gen + 1u) * nloc) {
            __builtin_amdgcn_fence(__ATOMIC_RELEASE, "agent");
            asm volatile("s_waitcnt vmcnt(0)" ::: "memory");
            const unsigned og = xb_add(&bar[XB_TOP], 1u);
            const unsigned tg = og / nx;
            if (og + 1u == (tg + 1u) * nx) xb_add(&bar[XB_TOPGEN], 1u);
            else XB_SPIN(xb_ld(&bar[XB_TOPGEN]) == tg, bar);
            __builtin_amdgcn_fence(__ATOMIC_ACQUIRE, "agent");
            xb_add(&bar[XB_XGEN(b.x)], 1u);
            asm volatile("s_waitcnt vmcnt(0)" ::: "memory");
        } else {
            XB_SPIN(xb_ld(&bar[XB_XGEN(b.x)]) == gen, bar);
            __builtin_amdgcn_fence(__ATOMIC_ACQUIRE, "agent");
            asm volatile("s_waitcnt vmcnt(0)" ::: "memory");
        }
    }
    __syncthreads();
}

__device__ __forceinline__ void team_barrier(unsigned* cnt, unsigned expected, unsigned* tmo) {
    asm volatile("s_waitcnt vmcnt(0)" ::: "memory");
    __syncthreads();
    if (threadIdx.x == 0) {
        __builtin_amdgcn_fence(__ATOMIC_RELEASE, "agent");
        asm volatile("s_waitcnt vmcnt(0)" ::: "memory");
        (void)xb_add(cnt, 1u);
        unsigned sp = 0u;
        while (xb_ld(cnt) < expected) { __builtin_amdgcn_s_sleep(2); if ((++sp & 255u) == 0u) { if (xb_ld(tmo)) break; if (sp > XB_SPIN_CAP) { atomicAdd(tmo, 1u); break; } } }
        __builtin_amdgcn_fence(__ATOMIC_ACQUIRE, "agent");
        asm volatile("s_waitcnt vmcnt(0)" ::: "memory");
    }
    __syncthreads();
}

__device__ __forceinline__ void team_wait(unsigned* cnt, unsigned expected, unsigned* tmo) {
    if (threadIdx.x == 0) {
        unsigned sp = 0u;
        while (xb_ld(cnt) < expected) { __builtin_amdgcn_s_sleep(8); if ((++sp & 255u) == 0u) { if (xb_ld(tmo)) break; if (sp > XB_SPIN_CAP) { atomicAdd(tmo, 1u); break; } } }
        __builtin_amdgcn_fence(__ATOMIC_ACQUIRE, "agent");
        asm volatile("s_waitcnt vmcnt(0)" ::: "memory");
    }
    __syncthreads();
}
constexpr int NWAVES = 8;
typedef short v4i16_t __attribute__((ext_vector_type(4)));
typedef unsigned u32x2 __attribute__((ext_vector_type(2)));
typedef float f32x2v __attribute__((ext_vector_type(2)));
typedef __bf16 bf16x2_t __attribute__((ext_vector_type(2)));
typedef unsigned u32x4 __attribute__((ext_vector_type(4)));
__device__ __forceinline__ unsigned cvtpk(float lo, float hi) { f32x2v v = {lo, hi}; bf16x2_t b = __builtin_convertvector(v, bf16x2_t); return __builtin_bit_cast(unsigned, b); }
__device__ __forceinline__ float bf2f(unsigned short u) { return __uint_as_float((unsigned)u << 16); }
__device__ __forceinline__ unsigned short f2bf16(float f) { return (unsigned short)(cvtpk(f, 0.f) & 0xffffu); }
__device__ __forceinline__ v4i16_t ldtr(LAS unsigned char* p) { return __builtin_amdgcn_ds_read_tr16_b64_v4i16((LAS v4i16_t*)p); }
__device__ __forceinline__ bf16x8 cat8(v4i16_t a, v4i16_t b) { return (bf16x8){a[0], a[1], a[2], a[3], b[0], b[1], b[2], b[3]}; }
__device__ __forceinline__ bf16x8 pack8(f32x4 a, f32x4 b) { u32x4 w; w.x = cvtpk(a[0], a[1]); w.y = cvtpk(a[2], a[3]); w.z = cvtpk(b[0], b[1]); w.w = cvtpk(b[2], b[3]); return __builtin_bit_cast(bf16x8, w); }
#define MFMA16(a, b, c) __builtin_amdgcn_mfma_f32_16x16x32_bf16((a), (b), (c), 0, 0, 0)

__device__ __forceinline__ float red4_max(float x) {
    auto a = __builtin_amdgcn_permlane16_swap(__float_as_uint(x), __float_as_uint(x), false, false); x = fmaxf(__uint_as_float(a[0]), __uint_as_float(a[1]));
    auto b = __builtin_amdgcn_permlane32_swap(__float_as_uint(x), __float_as_uint(x), false, false); return fmaxf(__uint_as_float(b[0]), __uint_as_float(b[1]));
}
__device__ __forceinline__ float red4_sum(float x) {
    auto a = __builtin_amdgcn_permlane16_swap(__float_as_uint(x), __float_as_uint(x), false, false); x = __uint_as_float(a[0]) + __uint_as_float(a[1]);
    auto b = __builtin_amdgcn_permlane32_swap(__float_as_uint(x), __float_as_uint(x), false, false); return __uint_as_float(b[0]) + __uint_as_float(b[1]);
}

struct Frame {
    LAS unsigned char* lds;
    volatile LAS unsigned* MISC;
    unsigned char* ws;
    int tid, lane, wave, G;
    const float *xp, *xs, *g1, *w_in, *upf, *bf_, *upb, *bb, *gng, *w_out, *g2, *w_gate, *w_up, *w_down, *gfin;
    float* out;
};
__device__ __forceinline__ float wave_sum(float v) {
#pragma unroll
    for (int o = 1; o < 64; o <<= 1) v += __shfl_xor(v, o);
    return v;
}

template <class RowMap>
__device__ __forceinline__ void p0_transpose_item(const float* W, int K, int N, int nblk, bf16* WT, const float* kscale, LAS float* scr, int item, int lane, RowMap rowmap) {
    const int kb = item / nblk, nb = item % nblk, k0 = 64 * kb, n0 = 32 * nb;
    float wv[32];
#pragma unroll
    for (int i = 0; i < 32; ++i) wv[i] = W[(size_t)(k0 + 2 * i + (lane >> 5)) * N + n0 + (lane & 31)];
#pragma unroll
    for (int i = 0; i < 32; ++i) { const int kk = 2 * i + (lane >> 5); float v = wv[i]; if (kscale) v *= kscale[k0 + kk]; scr[kk * 33 + (lane & 31)] = v; }
    LDS_WAIT(); asm volatile("" ::: "memory");
    const int c = lane & 7;
#pragma unroll
    for (int j = 0; j < 4; ++j) { const int n = (lane >> 3) + 8 * j; const LAS float* s = scr + (8 * c) * 33 + n;
        v4u o; o.x = pk2(s[0 * 33], s[1 * 33]); o.y = pk2(s[2 * 33], s[3 * 33]); o.z = pk2(s[4 * 33], s[5 * 33]); o.w = pk2(s[6 * 33], s[7 * 33]);
        *(GAS v4u*)(WT + (size_t)rowmap(n0 + n) * K + k0 + 8 * c) = o; }
    LDS_WAIT(); asm volatile("" ::: "memory");
}
struct RowIn { __device__ __forceinline__ int operator()(int n) const {
    if (n >= 1024) return n;
    const int d = n & 63, nn = d >> 5, dd = d & 31;
    return (n & ~63) + 32 * (dd >> 4) + 8 * ((dd >> 2) & 3) + 4 * nn + (dd & 3); } };
struct RowId { __device__ __forceinline__ int operator()(int n) const { return n; } };
struct RowGU { int off; __device__ __forceinline__ int operator()(int n) const { return 256 * (n >> 7) + off + (n & 127); } };

__device__ __forceinline__ void p0_prologue(Frame& F) {
    LAS float* scr = (LAS float*)(F.lds + 69632 + F.wave * 8448);
    const int gw = blockIdx.x * NWAVES + F.wave, NGW = F.G * NWAVES;
    { const int t = F.tid, c4 = 4 * (t & 7);
#pragma unroll 4
      for (int i = 0; i < 16; ++i) { const int k = (t >> 3) + 64 * i; const f32x4 w = *(const GAS f32x4*)(F.w_in + (size_t)k * NIN + 3072 + c4);
#pragma unroll
          for (int e = 0; e < 4; ++e) { const int col = c4 + e; *(LAS unsigned short*)(F.lds + (((k >> 5) * 2 + (col >> 4)) * 64 + ((k >> 3) & 3) * 16 + (col & 15)) * 16 + (k & 7) * 2) = f2bf16(w[e] * F.g1[k]); } }
    }
    __syncthreads();
    bf16* Win = (bf16*)(F.ws + WS_WIN); bf16* Wout = (bf16*)(F.ws + WS_WOUT); bf16* Wgu = (bf16*)(F.ws + WS_WGU); bf16* Wdn = (bf16*)(F.ws + WS_WDN);
    constexpr int I_IN = 16 * 96, I_OUT = 16 * 32, I_G = 16 * (DFF / 32), I_D = (DFF / 64) * 32;
    constexpr int NITEMS = I_IN + I_OUT + 2 * I_G + I_D;
    for (int it = gw; it < NITEMS; it += NGW) {
        int r = it;
        if (r < I_IN) { p0_transpose_item(F.w_in, DM, NIN, 96, Win, F.g1, scr, r, F.lane, RowIn{}); continue; } r -= I_IN;
        if (r < I_OUT) { p0_transpose_item(F.w_out, DM, DM, 32, Wout, nullptr, scr, r, F.lane, RowId{}); continue; } r -= I_OUT;
        if (r < I_G) { p0_transpose_item(F.w_gate, DM, DFF, DFF / 32, Wgu, F.g2, scr, r, F.lane, RowGU{0}); continue; } r -= I_G;
        if (r < I_G) { p0_transpose_item(F.w_up, DM, DFF, DFF / 32, Wgu, F.g2, scr, r, F.lane, RowGU{128}); continue; } r -= I_G;
        p0_transpose_item(F.w_down, DFF, DM, 32, Wdn, nullptr, scr, r, F.lane, RowId{});
    }
    { const int gt = blockIdx.x * 512 + F.tid, NT = F.G * 512; v4u z = {0u, 0u, 0u, 0u};
      for (int i = gt; i < MT / 4; i += NT) { *(GAS v4u*)((float*)(F.ws + WS_SS1) + 4 * i) = z; *(GAS v4u*)((float*)(F.ws + WS_SS2) + 4 * i) = z; } }
    { const int gt = blockIdx.x * 512 + F.tid, NT = F.G * 512; float* rc = (float*)(F.ws + WS_ROPE); float* rs = rc + 8192 * 32;
      for (int i = gt; i < 8192 * 32; i += NT) { const int s = i >> 5, f = i & 31;
          const float inv = (float)pow(10000.0, -(double)f / 32.0); const float ang = (float)s * inv;
          rc[i] = (float)cos((double)ang); rs[i] = (float)sin((double)ang); } }
    { bf16* HN = (bf16*)(F.ws + WS_HN); float* R0 = (float*)(F.ws + WS_R0); float* RFB = (float*)(F.ws + WS_RFB);
      const int lane = F.lane, lq = lane & 15, g = lane >> 4;
      const LAS unsigned char* wrf = F.lds;
      const int per = (MT / 16 + F.G - 1) / F.G, gend = ((int)blockIdx.x + 1) * per < MT / 16 ? ((int)blockIdx.x + 1) * per : MT / 16;
      for (int grp = blockIdx.x * per + F.wave; grp < gend; grp += NWAVES) {
          const int row = grp * 16 + lq;
          const float* xrow = (row < MP ? F.xp + (size_t)row * DM : F.xs + (size_t)(row - MP) * DM) + 8 * g;
          bf16* hrow = HN + (size_t)row * DM + 8 * g;
          f32x4 acc0 = {0.f, 0.f, 0.f, 0.f}, acc1 = {0.f, 0.f, 0.f, 0.f}, sq = {0.f, 0.f, 0.f, 0.f};
#pragma unroll 1
          for (int s0 = 0; s0 < 32; s0 += 8) {
              f32x4 xa[8], xb[8];
#pragma unroll
              for (int s = 0; s < 8; ++s) { xa[s] = *(const GAS f32x4*)(xrow + 32 * (s0 + s)); xb[s] = *(const GAS f32x4*)(xrow + 32 * (s0 + s) + 4); }
#pragma unroll
              for (int s = 0; s < 8; ++s) {
                  sq = sq + xa[s] * xa[s] + xb[s] * xb[s];
                  const bf16x8 af = pack8(xa[s], xb[s]);
                  *(bf16x8*)(hrow + 32 * (s0 + s)) = af;
                  acc0 = MFMA16(af, *(const LAS bf16x8*)(wrf + (((s0 + s) * 2 + 0) * 64 + lane) * 16), acc0);
                  acc1 = MFMA16(af, *(const LAS bf16x8*)(wrf + (((s0 + s) * 2 + 1) * 64 + lane) * 16), acc1);
              }
          }
          const float ss = red4_sum((sq[0] + sq[1]) + (sq[2] + sq[3]));
          const float r = 1.0f / sqrtf(ss * (1.0f / DM) + EPS);
          if (g == 0) R0[row] = r;
#pragma unroll
          for (int e = 0; e < 4; ++e) { const float re = __shfl(r, 4 * g + e);
              RFB[(size_t)(grp * 16 + 4 * g + e) * 32 + lq] = acc0[e] * re; RFB[(size_t)(grp * 16 + 4 * g + e) * 32 + 16 + lq] = acc1[e] * re; }
      } }
}

__device__ __forceinline__ void p8_final(Frame& F) {
    const int gw = blockIdx.x * NWAVES + F.wave, NGW = F.G * NWAVES;
    const float* ss = (const float*)(F.ws + WS_SS2);
    f32x4 gv[2][2];
#pragma unroll
    for (int hh = 0; hh < 2; ++hh)
#pragma unroll
        for (int j = 0; j < 2; ++j) gv[hh][j] = *(const GAS f32x4*)(F.gfin + hh * 512 + 8 * F.lane + 4 * j);
    const bf16* X2 = (const bf16*)(F.ws + WS_MIX);
    for (int m0 = gw; m0 < MT; m0 += 8 * NGW) {
        int mr[8]; v4u w[8][2]; float r[8];
#pragma unroll
        for (int k = 0; k < 8; ++k) { mr[k] = (m0 + k * NGW < MT) ? m0 + k * NGW : m0;
            const GAS v4u* xr = (const GAS v4u*)(X2 + (size_t)mr[k] * DM) + F.lane;
            w[k][0] = xr[0]; w[k][1] = xr[64];
            r[k] = __hip_atomic_load(ss + mr[k], __ATOMIC_RELAXED, __HIP_MEMORY_SCOPE_AGENT); }
#pragma unroll
        for (int k = 0; k < 8; ++k) { const float rr = 1.0f / sqrtf(r[k] * (1.0f / DM) + EPS);
#pragma unroll
            for (int hh = 0; hh < 2; ++hh) { const v4u q = w[k][hh]; GAS f32x4* o = (GAS f32x4*)(F.out + (size_t)mr[k] * DM + hh * 512 + 8 * F.lane);
                const f32x4 a = {__uint_as_float(q.x << 16), __uint_as_float(q.x & 0xffff0000u), __uint_as_float(q.y << 16), __uint_as_float(q.y & 0xffff0000u)};
                const f32x4 b = {__uint_as_float(q.z << 16), __uint_as_float(q.z & 0xffff0000u), __uint_as_float(q.w << 16), __uint_as_float(q.w & 0xffff0000u)};
                o[0] = a * rr * gv[hh][0]; o[1] = b * rr * gv[hh][1]; } }
    }
}
struct AttnGeom { int seq_base, log2d, r, m0, tlo, thi; };
__device__ __forceinline__ void attn_geom(AttnGeom& G, int seq_base, int S, int c, int pi, int sb) {
    const int log2d = pi == 0 ? 4 : (pi == 1 ? 2 : 0), L = S >> log2d, Mres = 512 >> log2d, lg = 4 - log2d;
    G.seq_base = seq_base; G.log2d = log2d; G.r = sb >> lg; G.m0 = Mres * c + 32 * (sb & ((1 << lg) - 1));
    G.tlo = G.m0 >= 64 ? 0 : (G.m0 >= 32 ? 1 : 2);
    const int rem = L - G.m0; G.thi = rem >= 96 ? 4 : (rem >= 64 ? 3 : 2);
}
__device__ __forceinline__ int attn_row(const AttnGeom& G, int m) { return G.seq_base + (m << G.log2d) + G.r; }
__device__ __forceinline__ void attn_dma_k(const AttnGeom& G, int t, const bf16* KA, int h, int lane, LAS unsigned char* slot) {
    const int mk0 = G.m0 - 64 + 32 * t;
#pragma unroll
    for (int i = 0; i < 4; ++i) { const int row = 8 * i + (lane >> 3), p = lane & 7;
        __builtin_amdgcn_global_load_lds((const unsigned*)((const char*)KA + (unsigned)(attn_row(G, mk0 + row) * 1024 + h * 128 + 16 * (p ^ ((row >> 1) & 7)))), (LAS unsigned*)(slot + i * 1024), 16, 0, 0); }
}
__device__ __forceinline__ void attn_load_v(u32x4 (&vv)[4], const AttnGeom& G, int t, const bf16* VA, int h, int lane) {
    const int mk0 = G.m0 - 64 + 32 * t;
#pragma unroll
    for (int i = 0; i < 4; ++i) vv[i] = *(const u32x4*)((const char*)VA + (unsigned)(attn_row(G, mk0 + 8 * i + (lane >> 3)) * 1024 + h * 128 + 16 * (lane & 7)));
}

struct AttnLdsOff { int k0, vb, vx, vw0; };
template <int NQB, int PM> __device__ __forceinline__ void attn_pattern(Frame& F, const AttnGeom& G0, const AttnGeom& G1, unsigned tl0, int n0, unsigned tl1, int n1,
                                                                         int pi, int tok0, int h, LAS unsigned char* ring, LAS unsigned char* sto, LAS float* stm, LAS float* stl) {
    constexpr int NSEG = 4 / NQB;
    const int lane = F.lane, lq = lane & 15, g = lane >> 4, tq = (lane & 15) >> 2, tp = lane & 3;
    AttnLdsOff LO;
    LO.k0 = lq * 128 + ((g ^ ((lq >> 1) & 7)) << 4);
    { const int r = 4 * g + tq; LO.vx = (r >> 1) & 3; LO.vb = r * 128 + ((tp >> 1) << 4) + 8 * (tp & 1); }
    { const int row = lane >> 3, p = lane & 7; LO.vw0 = row * 128 + ((p ^ (2 * ((row >> 1) & 3))) << 4); }
    const bf16* MIX = (const bf16*)(F.ws + WS_MIX); bf16* MIXW = (bf16*)(F.ws + WS_MIX);
    const bf16* KA = (const bf16*)(F.ws + WS_KA); const bf16* VA = (const bf16*)(F.ws + WS_VA);
    const int ntot = n0 + (NSEG == 2 ? n1 : 0);
#define ATT_TILE(kk) (((kk) < n0 ? tl0 >> (4 * (kk)) : tl1 >> (4 * ((kk) - n0))) & 15u)
#define ATT_GEOM(kk) ((kk) < n0 ? G0 : G1)
    attn_dma_k(G0, (int)ATT_TILE(0), KA, h, lane, ring);
    attn_dma_k(ATT_GEOM(1), (int)ATT_TILE(1), KA, h, lane, ring + 4096);
    u32x4 vn[4]; attn_load_v(vn, G0, (int)ATT_TILE(0), VA, h, lane);
    int k = 0;
#pragma unroll 1
    for (int i = 0; i < NSEG; ++i) {
        const AttnGeom G = i == 0 ? G0 : G1; const int nseg_tiles = i == 0 ? n0 : n1;
        int qrow[NQB];
#pragma unroll
        for (int qb = 0; qb < NQB; ++qb) qrow[qb] = attn_row(G, G.m0 + 16 * qb + lq);
        bf16x8 bq[NQB][2];
#pragma unroll
        for (int qb = 0; qb < NQB; ++qb)
#pragma unroll
            for (int st = 0; st < 2; ++st) bq[qb][st] = *(const bf16x8*)((MIX + h * 64) + ((qrow[qb] * 1024 + 8 * g) + 32 * st));
        constexpr bool ACCM = NQB == 2;
        f32x4 O[4][NQB], negm[ACCM ? NQB : 1]; float mneg[NQB], lrun[NQB];
        bool fresh = (pi == 0 || PM == 1);
        if (fresh) {
#pragma unroll
            for (int qb = 0; qb < NQB; ++qb) { mneg[qb] = 0.f; lrun[qb] = 0.f;
#pragma unroll
                for (int db = 0; db < 4; ++db) O[db][qb] = (f32x4){0.f, 0.f, 0.f, 0.f}; }
        } else {
#pragma unroll
            for (int qb = 0; qb < NQB; ++qb) { const int ti = qrow[qb] - tok0;
#pragma unroll
                for (int db = 0; db < 4; ++db) { const u32x2 w = *(LAS u32x2*)(sto + ti * 136 + 32 * db + 8 * g);
                    O[db][qb] = (f32x4){__uint_as_float(w.x << 16), __uint_as_float(w.x & 0xffff0000u), __uint_as_float(w.y << 16), __uint_as_float(w.y & 0xffff0000u)}; }
                mneg[qb] = -stm[ti]; const float lt = stl[ti]; lrun[qb] = g == 0 ? lt : 0.f; }
        }
        if constexpr (ACCM) {
#pragma unroll
            for (int qb = 0; qb < NQB; ++qb) negm[qb] = (f32x4){mneg[qb], mneg[qb], mneg[qb], mneg[qb]}; }
#pragma unroll 1
        for (int j = 0; j < nseg_tiles; ++j, ++k) {
            const int t = (int)ATT_TILE(k);
            LAS unsigned char* slot = ring + (k & 1) * 4096;
            if (k + 1 < ntot) asm volatile("s_waitcnt vmcnt(8)" ::: "memory"); else asm volatile("s_waitcnt vmcnt(4)" ::: "memory");
            bf16x8 ak[2][2];
#pragma unroll
            for (int kb = 0; kb < 2; ++kb)
#pragma unroll
                for (int st = 0; st < 2; ++st) ak[kb][st] = *(LAS bf16x8*)(slot + (LO.k0 ^ (64 * st)) + kb * 2048);
            bf16x8 pb[NQB];
            const bool edge = NQB == 2 ? (t == 0 || t == 4) : (t != 2 && t != 3);
            const int lo = -32 * t, hi = 128 - 32 * t;
#pragma unroll
            for (int q0 = 0; q0 < NQB; q0 += 2) {
                f32x4 s[2][2];
#pragma unroll
                for (int kb = 0; kb < 2; ++kb)
#pragma unroll
                    for (int qq = 0; qq < 2; ++qq) { s[kb][qq] = MFMA16(ak[kb][0], bq[q0 + qq][0], ACCM ? negm[ACCM ? q0 + qq : 0] : ((f32x4){0.f, 0.f, 0.f, 0.f})); s[kb][qq] = MFMA16(ak[kb][1], bq[q0 + qq][1], s[kb][qq]); if constexpr (!ACCM) s[kb][qq] = s[kb][qq] + mneg[q0 + qq]; }
                if (edge) {
#pragma unroll
                    for (int kb = 0; kb < 2; ++kb)
#pragma unroll
                        for (int qq = 0; qq < 2; ++qq)
#pragma unroll
                            for (int e = 0; e < 4; ++e) { const int dlt = (16 * kb + 4 * g + e) - (16 * (q0 + qq) + lq); if (dlt < lo || dlt > hi) s[kb][qq][e] = -1e30f; }
                }
                float mx[2];
#pragma unroll
                for (int qq = 0; qq < 2; ++qq) mx[qq] = red4_max(fmaxf(fmaxf(fmaxf(s[0][qq][0], s[0][qq][1]), fmaxf(s[0][qq][2], s[0][qq][3])), fmaxf(fmaxf(s[1][qq][0], s[1][qq][1]), fmaxf(s[1][qq][2], s[1][qq][3]))));
                if (fresh || __any(mx[0] > 0.f || mx[1] > 0.f)) {
#pragma unroll
                    for (int qq = 0; qq < 2; ++qq) { const int qb = q0 + qq;
                        const float d = fresh ? mx[qq] : fmaxf(mx[qq], 0.f), alpha = fresh ? 1.0f : __builtin_amdgcn_exp2f(-d);
                        mneg[qb] -= d; if constexpr (ACCM) negm[qb] = negm[qb] - d;
#pragma unroll
                        for (int kb = 0; kb < 2; ++kb) s[kb][qq] = s[kb][qq] - d;
                        lrun[qb] *= alpha;
#pragma unroll
                        for (int db = 0; db < 4; ++db) O[db][qb] = O[db][qb] * alpha;
                    }
                }
#pragma unroll
                for (int qq = 0; qq < 2; ++qq) { const int qb = q0 + qq;
                    f32x4 p0, p1;
#pragma unroll
                    for (int e = 0; e < 4; ++e) { p0[e] = __builtin_amdgcn_exp2f(s[0][qq][e]); p1[e] = __builtin_amdgcn_exp2f(s[1][qq][e]); }
                    lrun[qb] += ((p0[0] + p0[1]) + (p0[2] + p0[3])) + ((p1[0] + p1[1]) + (p1[2] + p1[3]));
                    pb[qb] = pack8(p0, p1);
                }
                if (NQB == 4 && q0 == 0) asm volatile("" : "+v"(ak[0][0]), "+v"(ak[0][1]), "+v"(ak[1][0]), "+v"(ak[1][1]) : "v"(pb[0]), "v"(pb[1]));
            }
            fresh = false;
#pragma unroll
            for (int i4 = 0; i4 < 4; ++i4) *(LAS u32x4*)(slot + LO.vw0 + i4 * 1024) = vn[i4];
#pragma unroll
            for (int db = 0; db < 4; ++db) {
                const bf16x8 av = cat8(ldtr(slot + LO.vb + ((db ^ LO.vx) << 5)), ldtr(slot + LO.vb + ((db ^ LO.vx) << 5) + 2048));
#pragma unroll
                for (int qb = 0; qb < NQB; ++qb) O[db][qb] = MFMA16(av, pb[qb], O[db][qb]);
            }
            asm volatile("s_waitcnt lgkmcnt(0)" ::: "memory");
            if (k + 2 < ntot) attn_dma_k(ATT_GEOM(k + 2), (int)ATT_TILE(k + 2), KA, h, lane, slot);
            { const int k1 = k + 1 < ntot ? k + 1 : k; attn_load_v(vn, ATT_GEOM(k1), (int)ATT_TILE(k1), VA, h, lane); }
        }
#pragma unroll
        for (int qb = 0; qb < NQB; ++qb) {
            float lt = red4_sum(lrun[qb]);
            if (PM == 1 && pi < 2) { asm volatile("" :: "v"(O[0][qb]), "v"(O[1][qb]), "v"(O[2][qb]), "v"(O[3][qb]), "v"(lt)); }
            else if (pi < 2) { const int ti = attn_row(G, G.m0 + 16 * qb + lq) - tok0;
#pragma unroll
                for (int db = 0; db < 4; ++db) { u32x2 w; w.x = cvtpk(O[db][qb][0], O[db][qb][1]); w.y = cvtpk(O[db][qb][2], O[db][qb][3]); *(LAS u32x2*)(sto + ti * 136 + 32 * db + 8 * g) = w; }
                if (g == 0) { stm[ti] = -mneg[qb]; stl[ti] = lt; }
            } else { const float inv = 1.0f / lt;
#pragma unroll
                for (int db = 0; db < 4; ++db) { const f32x4 o = O[db][qb] * inv; u32x2 w; w.x = cvtpk(o[0], o[1]); w.y = cvtpk(o[2], o[3]);
                    *(u32x2*)((MIXW + h * 64) + ((attn_row(G, G.m0 + 16 * qb + lq) * 1024 + 4 * g) + 16 * db)) = w; }
            }
        }
    }
#undef ATT_TILE
#undef ATT_GEOM
}

template <int PM> __device__ __forceinline__ void attn_phase(Frame& F, unsigned* queue) {
    const int wave = F.wave;
    LAS unsigned char* ring = F.lds + wave * 8192;
    LAS unsigned char* sto = F.lds + 65536;
    LAS float* stm = (LAS float*)(F.lds + 65536 + 512 * 136); LAS float* stl = stm + 512;
    for (int item = blockIdx.x;; item += F.G) {
        if (queue) {
            if (F.tid == 0) F.MISC[20] = __hip_atomic_fetch_add(queue, 1u, __ATOMIC_RELAXED, __HIP_MEMORY_SCOPE_AGENT);
            __syncthreads();
            item = (int)F.MISC[20];
        }
        if (item >= (MT / 512) * 8) break;
        const int cc = item >> 3, h = item & 7, tok0 = cc * 512;
        const int S = tok0 < MP ? 4096 : 8192, seq_base = tok0 & ~(S - 1), c = (tok0 - seq_base) >> 9;
        {
            AttnGeom G0, G1; attn_geom(G0, seq_base, S, c, 0, 2 * wave); attn_geom(G1, seq_base, S, c, 0, 2 * wave + 1);
            unsigned tl0 = 0, tl1 = 0; int n0 = 0, n1 = 0;
            for (int t = G0.tlo; t <= G0.thi; ++t) tl0 |= (unsigned)t << (4 * n0++);
            for (int t = G1.tlo; t <= G1.thi; ++t) tl1 |= (unsigned)t << (4 * n1++);
            attn_pattern<2, PM>(F, G0, G1, tl0, n0, tl1, n1, 0, tok0, h, ring, sto, stm, stl);
            __syncthreads();
        }
#pragma unroll 1
        for (int pi = 1; pi < 3; ++pi) {
            AttnGeom G0; attn_geom(G0, seq_base, S, c, pi, 2 * wave);
            const int L = S >> G0.log2d, m0 = G0.m0;
            unsigned tl0 = 2u | (3u << 4); int n0 = 2;
            if (m0 >= 32) tl0 |= 1u << (4 * n0++);
            if (m0 + 96 <= L) tl0 |= 4u << (4 * n0++);
            if (m0 >= 64) tl0 |= 0u << (4 * n0++);
            if (m0 + 128 <= L) tl0 |= 5u << (4 * n0++);
            attn_pattern<4, PM>(F, G0, G0, tl0, n0, 0u, 0, pi, tok0, h, ring, sto, stm, stl);
            __syncthreads();
        }
    }
}
__device__ __forceinline__ void gla_load_v(Frame& F, int row0) {
    const bf16* VG = (const bf16*)(F.ws + WS_VG);
#pragma unroll
    for (int i = 0; i < 8; ++i) { const int s = F.wave + 8 * i;
        const u32x4 v = *(const u32x4*)(VG + (size_t)(row0 + s) * 512 + 8 * F.lane);
        *(LAS u32x4*)(F.lds + G_VT + (F.lane >> 4) * G_VT_HEAD + s * 288 + (F.lane & 15) * 16) = v; }
}

__device__ __forceinline__ void gla_g1(Frame& F, int first, int GS) {
    const int lane = F.lane, wave = F.wave, lq = lane & 15, g = lane >> 4, tq = (lane & 15) >> 2, tp = lane & 3;
    const int h = wave >> 1, dir = wave & 1;
    const bf16* __restrict__ MIX = (const bf16*)(F.ws + WS_MIX);
    bf16* __restrict__ QE = (bf16*)(F.ws + WS_QE) + (size_t)(2 * dir) * QE_STRIDE; bf16* __restrict__ KE = (bf16*)(F.ws + WS_QE) + (size_t)(2 * dir + 1) * QE_STRIDE;
    bf16* KVT = (bf16*)(F.ws + WS_KVT); float* DEC = (float*)(F.ws + WS_DECAY);
    const float* RFB = (const float*)(F.ws + WS_RFB);
    const float* up = dir ? F.upb : F.upf; const float* bias = dir ? F.bb : F.bf_;
    f32x4 up4[4];
#pragma unroll
    for (int r = 0; r < 16; ++r) up4[r >> 2][r & 3] = up[r * 256 + h * 64 + lane] * 1.4426950408889634f;
    const float bs = bias[h * 64 + lane] * 1.4426950408889634f;
    LAS float* rfl = (LAS float*)(F.lds + G_RF) + dir * 1024;
    LAS unsigned char* kel = F.lds + G_KE + wave * 9216;
    LAS float* cl = (LAS float*)(F.lds + G_CL) + wave * 64;
    LAS unsigned char* vt = F.lds + G_VT + h * G_VT_HEAD;
    const bf16* VG = (const bf16*)(F.ws + WS_VG);
    const int rs = F.tid >> 3, rch = F.tid & 7;
    int ci = first;
    if (ci >= NCHUNK) return;
    f32x4 rfreg = *(const f32x4*)(RFB + (size_t)(ci * 64 + rs) * 32 + 4 * rch);
    unsigned short qn[16], kn[16];
#pragma unroll
    for (int j = 0; j < 16; ++j) { const size_t row = (size_t)(ci * 64 + (dir ? 63 - j : j)); qn[j] = MIX[row * 1024 + 512 + h * 64 + lane]; kn[j] = MIX[row * 1024 + 768 + h * 64 + lane]; }
    for (;;) {
        const int row0 = ci * 64, cn = ci + GS; const bool has_next = cn < NCHUNK;
        *(LAS f32x4*)((LAS float*)(F.lds + G_RF) + (rch >> 2) * 1024 + rs * 16 + 4 * (rch & 3)) = rfreg;
        __syncthreads();
        u32x4 vr[8];
#pragma unroll
        for (int i = 0; i < 8; ++i) vr[i] = *(const u32x4*)(VG + (size_t)(row0 + wave + 8 * i) * 512 + 8 * lane);
        float cum = 0.f;
#pragma unroll 1
        for (int b = 0; b < 4; ++b) {
            unsigned short qc[16], kc[16];
#pragma unroll
            for (int j = 0; j < 16; ++j) { qc[j] = qn[j]; kc[j] = kn[j]; }
            if (b < 3) {
#pragma unroll
                for (int j = 0; j < 16; ++j) { const int ss = 16 * (b + 1) + j; const size_t row = (size_t)(row0 + (dir ? 63 - ss : ss)); qn[j] = MIX[row * 1024 + 512 + h * 64 + lane]; kn[j] = MIX[row * 1024 + 768 + h * 64 + lane]; }
            }
#pragma unroll
            for (int jb = 0; jb < 4; ++jb) {
                f32x4 rr[4][4];
#pragma unroll
                for (int j4 = 0; j4 < 4; ++j4) { const int ss = 16 * b + 4 * jb + j4, s = dir ? 63 - ss : ss;
#pragma unroll
                    for (int q = 0; q < 4; ++q) rr[j4][q] = *(LAS f32x4*)(rfl + s * 16 + 4 * q); }
                float la[4];
#pragma unroll
                for (int j4 = 0; j4 < 4; ++j4) {
                    const f32x4 z4 = rr[j4][0] * up4[0] + rr[j4][1] * up4[1] + rr[j4][2] * up4[2] + rr[j4][3] * up4[3];
                    const float z = bs + ((z4[0] + z4[1]) + (z4[2] + z4[3]));
                    la[j4] = fminf(z, 0.f) - __builtin_amdgcn_logf(1.0f + __builtin_amdgcn_exp2f(-fabsf(z)));
                }
#pragma unroll
                for (int j4 = 0; j4 < 4; ++j4) { const int j = 4 * jb + j4, ss = 16 * b + j, s = dir ? 63 - ss : ss;
                    cum = __builtin_fmaf(la[j4], 1.0f / 16.0f, cum);
                    const size_t row = (size_t)(row0 + s);
                    const float e = __builtin_amdgcn_exp2f(cum), qe = bf2f(qc[j]) * e, ke = bf2f(kc[j]) * __builtin_amdgcn_rcpf(e);
                    const unsigned short keb = f2bf16(ke);
                    QE[row * 256 + h * 64 + lane] = f2bf16(qe); KE[row * 256 + h * 64 + lane] = keb;
                    *(LAS unsigned short*)(kel + lane * 144 + s * 2) = keb;
                }
            }
        }
        cl[lane] = cum;
        const int itemi = (ci * 4 + h) * 2 + dir;
        DEC[(size_t)itemi * 64 + lane] = __builtin_amdgcn_exp2f(cum);
#pragma unroll
        for (int i = 0; i < 8; ++i) *(LAS u32x4*)(F.lds + G_VT + (lane >> 4) * G_VT_HEAD + (wave + 8 * i) * 288 + (lane & 15) * 16) = vr[i];
        __syncthreads();
        { const int cl_ = has_next ? cn : ci;
          rfreg = *(const f32x4*)(RFB + (size_t)(cl_ * 64 + rs) * 32 + 4 * rch);
#pragma unroll
          for (int j = 0; j < 16; ++j) { const size_t row = (size_t)(cl_ * 64 + (dir ? 63 - j : j)); qn[j] = MIX[row * 1024 + 512 + h * 64 + lane]; kn[j] = MIX[row * 1024 + 768 + h * 64 + lane]; } }
        bf16x8 af[4][2];
#pragma unroll
        for (int cb = 0; cb < 4; ++cb)
#pragma unroll
            for (int ks = 0; ks < 2; ++ks) af[cb][ks] = *(LAS bf16x8*)(kel + (16 * cb + lq) * 144 + (32 * ks + 8 * g) * 2);
        f32x4 scl[4];
#pragma unroll
        for (int cb = 0; cb < 4; ++cb) { const f32x4 c4 = *(LAS f32x4*)(cl + 16 * cb + 4 * g); scl[cb] = (f32x4){__builtin_amdgcn_exp2f(c4[0]), __builtin_amdgcn_exp2f(c4[1]), __builtin_amdgcn_exp2f(c4[2]), __builtin_amdgcn_exp2f(c4[3])}; }
#pragma unroll 1
        for (int half = 0; half < 2; ++half) {
            f32x4 acc[4][4];
#pragma unroll
            for (int cb = 0; cb < 4; ++cb)
#pragma unroll
                for (int d = 0; d < 4; ++d) acc[cb][d] = (f32x4){0.f, 0.f, 0.f, 0.f};
#pragma unroll
            for (int d = 0; d < 4; ++d) { const int db = half * 4 + d;
#pragma unroll
                for (int ks = 0; ks < 2; ++ks) {
                    const bf16x8 bv = cat8(ldtr(vt + (32 * ks + 8 * g + tq) * 288 + (16 * db + 4 * tp) * 2), ldtr(vt + (32 * ks + 8 * g + 4 + tq) * 288 + (16 * db + 4 * tp) * 2));
#pragma unroll
                    for (int cb = 0; cb < 4; ++cb) acc[cb][d] = MFMA16(af[cb][ks], bv, acc[cb][d]);
                } }
#pragma unroll
            for (int d = 0; d < 4; ++d) { const int dv = 16 * (half * 4 + d) + lq;
#pragma unroll
                for (int cb = 0; cb < 4; ++cb) { const f32x4 v = acc[cb][d] * scl[cb]; u32x2 w; w.x = cvtpk(v[0], v[1]); w.y = cvtpk(v[2], v[3]);
                    *(u32x2*)(KVT + (size_t)itemi * 8192 + (((half * 4 + d) * 2 + (cb >> 1)) * 64 + (2 * (cb & 1) + (g >> 1)) * 16 + lq) * 8 + 4 * (g & 1)) = w; } }
        }
        if (!has_next) break;
        ci = cn;
    }
    __syncthreads();
}

__device__ __forceinline__ void gla_g2(Frame& F, int first, int GS) {
    const bf16* KVT = (const bf16*)(F.ws + WS_KVT); const float* __restrict__ DEC = (const float*)(F.ws + WS_DECAY); bf16* ST = (bf16*)(F.ws + WS_KVT);
    for (int it = first; it < 768; it += GS) {
        int nch, cbase, rem;
        if (it < 256) { nch = 64; cbase = (it >> 6) * 64; rem = it & 63; } else { const int j = it - 256; nch = 128; cbase = 256 + (j >> 6) * 128; rem = j & 63; }
        const int h = rem >> 4, dir = (rem >> 3) & 1, part = rem & 7;
        const int e = part * 512 + F.tid, o2 = 2 * e, dk = 32 * ((o2 >> 9) & 1) + 8 * ((o2 >> 7) & 3) + (o2 & 7);
        float s0 = 0.f, s1 = 0.f;
        const size_t eoff = (size_t)o2;
        unsigned kvn[16]; f32x2v dcn[16];
#pragma unroll
        for (int j = 0; j < 16; ++j) { const int ci = cbase + (dir ? nch - 1 - j : j); const size_t itemi = (size_t)(ci * 4 + h) * 2 + dir;
            kvn[j] = *(const unsigned*)(KVT + itemi * 8192 + eoff); dcn[j] = *(const f32x2v*)(DEC + itemi * 64 + dk); }
#pragma unroll 1
        for (int n0 = 0; n0 < nch; n0 += 16) {
            unsigned kvc[16]; f32x2v dcc[16];
#pragma unroll
            for (int j = 0; j < 16; ++j) { kvc[j] = kvn[j]; dcc[j] = dcn[j]; }
            if (n0 + 16 < nch) {
#pragma unroll
                for (int j = 0; j < 16; ++j) { const int n = n0 + 16 + j; const int ci = cbase + (dir ? nch - 1 - n : n); const size_t itemi = (size_t)(ci * 4 + h) * 2 + dir;
                    kvn[j] = *(const unsigned*)(KVT + itemi * 8192 + eoff); dcn[j] = *(const f32x2v*)(DEC + itemi * 64 + dk); }
            }
#pragma unroll
            for (int j = 0; j < 16; ++j) { const int n = n0 + j; const int ci = cbase + (dir ? nch - 1 - n : n); const size_t itemi = (size_t)(ci * 4 + h) * 2 + dir;
                *(unsigned*)(ST + itemi * 8192 + eoff) = cvtpk(s0, s1);
                s0 = s0 * dcc[j].x + bf2f((unsigned short)(kvc[j] & 0xffffu)); s1 = s1 * dcc[j].y + bf2f((unsigned short)(kvc[j] >> 16)); }
        }
    }
}

struct G3A { bf16x8 bq[2][2]; bf16x8 ak[2][2][2]; };
struct G3S { bf16x8 as[8][2]; };
__device__ __forceinline__ void g3_load_a(G3A& R, const bf16* QEb, int ci, int h, int chalf, int dir, int lq, int g) {
    const bf16* qb = QEb + (size_t)(2 * dir) * QE_STRIDE + (size_t)(ci * 64) * 256 + h * 64;
    const bf16* kb = qb + QE_STRIDE;
    const int lo = lq * 256 + 8 * g, qo = lo + 32 * chalf * 256;
#pragma unroll
    for (int cb = 0; cb < 2; ++cb)
#pragma unroll
        for (int st = 0; st < 2; ++st) R.bq[cb][st] = *(const bf16x8*)(qb + (qo + (16 * cb * 256 + 32 * st)));
#pragma unroll
    for (int ks = 0; ks < 2; ++ks)
#pragma unroll
        for (int sb = 0; sb < 2; ++sb)
#pragma unroll
            for (int st = 0; st < 2; ++st) R.ak[ks][sb][st] = *(const bf16x8*)(kb + (lo + ((32 * ks + 16 * sb) * 256 + 32 * st)));
}
__device__ __forceinline__ void g3_load_s(G3S& R, const bf16* ST, int ci, int h, int dir, int lq, int g) {
    const bf16* sb = ST + ((size_t)(ci * 4 + h) * 2 + dir) * 8192;
    const int lo = (g * 16 + lq) * 8;
#pragma unroll
    for (int db = 0; db < 8; ++db)
#pragma unroll
        for (int st = 0; st < 2; ++st) R.as[db][st] = *(const bf16x8*)(sb + (lo + (db * 2 + st) * 512));
}
__device__ __forceinline__ void g3_intra(f32x4 (&O)[8][2], const G3A& R, LAS unsigned char* vt, int dir, int chalf, int lq, int g, int tq, int tp) {
#pragma unroll
    for (int ks = 0; ks < 2; ++ks) {
        bf16x8 pb[2];
#pragma unroll
        for (int cb = 0; cb < 2; ++cb) {
            f32x4 sa[2];
#pragma unroll
            for (int sb = 0; sb < 2; ++sb) { sa[sb] = MFMA16(R.ak[ks][sb][0], R.bq[cb][0], ((f32x4){0.f, 0.f, 0.f, 0.f})); sa[sb] = MFMA16(R.ak[ks][sb][1], R.bq[cb][1], sa[sb]);
#pragma unroll
                for (int e = 0; e < 4; ++e) { const int s = 32 * ks + 16 * sb + 4 * g + e, c = 32 * chalf + 16 * cb + lq; const bool keep = dir ? (s > c) : (s <= c); if (!keep) sa[sb][e] = 0.f; } }
            pb[cb] = pack8(sa[0], sa[1]);
        }
#pragma unroll
        for (int db = 0; db < 8; ++db) {
            const bf16x8 av = cat8(ldtr(vt + (32 * ks + 4 * g + tq) * 288 + (16 * db + 4 * tp) * 2), ldtr(vt + (32 * ks + 16 + 4 * g + tq) * 288 + (16 * db + 4 * tp) * 2));
#pragma unroll
            for (int cb = 0; cb < 2; ++cb) O[db][cb] = MFMA16(av, pb[cb], O[db][cb]);
        }
    }
}
__device__ __forceinline__ void g3_inter(f32x4 (&O)[8][2], const G3S& S, const bf16x8 (&bq)[2][2]) {
#pragma unroll
    for (int db = 0; db < 8; ++db)
#pragma unroll
        for (int st = 0; st < 2; ++st)
#pragma unroll
            for (int cb = 0; cb < 2; ++cb) O[db][cb] = MFMA16(S.as[db][st], bq[cb][st], O[db][cb]);
}
__device__ __forceinline__ void g3_keep_a(const G3A& R) {
#pragma unroll
    for (int a = 0; a < 2; ++a)
#pragma unroll
        for (int b = 0; b < 2; ++b) { asm volatile("" :: "v"(R.bq[a][b]));
#pragma unroll
            for (int c = 0; c < 2; ++c) asm volatile("" :: "v"(R.ak[a][b][c])); }
}
__device__ __forceinline__ void g3_keep_s(const G3S& R) {
#pragma unroll
    for (int db = 0; db < 8; ++db)
#pragma unroll
        for (int st = 0; st < 2; ++st) asm volatile("" :: "v"(R.as[db][st]));
}
template <int PM> __device__ __forceinline__ void gla_g3(Frame& F, unsigned* queue) {
    const int lane = F.lane, wave = F.wave, lq = lane & 15, g = lane >> 4, tq = (lane & 15) >> 2, tp = lane & 3;
    const int h = wave >> 1, chalf = wave & 1;
    const bf16* QEb = (const bf16*)(F.ws + WS_QE); const bf16* ST = (const bf16*)(F.ws + WS_KVT); const bf16* OG = (const bf16*)(F.ws + WS_OG);
    const bf16* VG = (const bf16*)(F.ws + WS_VG);
    bf16* MIXW = (bf16*)(F.ws + WS_MIX);
    int p = 0;
    if (F.tid == 0) F.MISC[21] = __hip_atomic_fetch_add(queue, 1u, __ATOMIC_RELAXED, __HIP_MEMORY_SCOPE_AGENT);
    __syncthreads();
    int ci = (int)F.MISC[21];
    __syncthreads();
    if (ci >= NCHUNK) return;
    u32x4 vr[8];
#pragma unroll
    for (int i = 0; i < 8; ++i) vr[i] = *(const u32x4*)((VG + (size_t)(ci * 64 + wave) * 512) + (8 * lane + 8 * i * 512));
    G3A A0; g3_load_a(A0, QEb, ci, h, chalf, 0, lq, g);
#pragma unroll
    for (int i = 0; i < 8; ++i) *(LAS u32x4*)(F.lds + G_VT + (lane >> 4) * G_VT_HEAD + (wave + 8 * i) * 288 + (lane & 15) * 16) = vr[i];
    __syncthreads();
    for (;;) {
        if (F.tid == 0) F.MISC[21] = __hip_atomic_fetch_add(queue, 1u, __ATOMIC_RELAXED, __HIP_MEMORY_SCOPE_AGENT);
        __syncthreads();
        const int row0 = ci * 64, cn = (int)F.MISC[21]; const bool has_next = cn < NCHUNK;
        LAS unsigned char* vt = F.lds + G_VT + p * (4 * G_VT_HEAD) + h * G_VT_HEAD;
        const int cl_ = PM == 2 ? (int)blockIdx.x + ((ci / F.G) & 1) * F.G : ci;
        G3S S0; g3_load_s(S0, ST, cl_, h, 0, lq, g);
        f32x4 O[8][2];
#pragma unroll
        for (int db = 0; db < 8; ++db)
#pragma unroll
            for (int cb = 0; cb < 2; ++cb) O[db][cb] = (f32x4){0.f, 0.f, 0.f, 0.f};
        if (PM != 1) g3_intra(O, A0, vt, 0, chalf, lq, g, tq, tp); else g3_keep_a(A0);
        G3A A1; g3_load_a(A1, QEb, cl_, h, chalf, 1, lq, g);
        if (PM != 1) g3_inter(O, S0, A0.bq); else g3_keep_s(S0);
        G3S S1; g3_load_s(S1, ST, cl_, h, 1, lq, g);
        if (PM != 1) g3_intra(O, A1, vt, 1, chalf, lq, g, tq, tp); else g3_keep_a(A1);
        if (PM != 1) g3_inter(O, S1, A1.bq); else g3_keep_s(S1);
        __builtin_amdgcn_sched_barrier(0);
        u32x2 ogw[8];
#pragma unroll
        for (int db = 0; db < 8; ++db) ogw[db] = *(const u32x2*)((OG + (size_t)((PM == 2 ? cl_ * 64 : row0) + 32 * chalf) * 512 + h * 128) + ((lq * 512 + 4 * g) + 16 * db));
        { const int cl = PM == 2 ? (int)blockIdx.x + ((cn / F.G) & 1) * F.G : (has_next ? cn : ci);
#pragma unroll
          for (int i = 0; i < 8; ++i) vr[i] = *(const u32x4*)((VG + (size_t)(cl * 64 + wave) * 512) + (8 * lane + 8 * i * 512));
          g3_load_a(A0, QEb, cl, h, chalf, 0, lq, g); }
#pragma unroll
        for (int cb = 0; cb < 2; ++cb) {
            float q = 0.f;
#pragma unroll
            for (int db = 0; db < 8; ++db) { const f32x4 v = O[db][cb]; q += (v[0] * v[0] + v[1] * v[1]) + (v[2] * v[2] + v[3] * v[3]); }
            q += __shfl_xor(q, 16); q += __shfl_xor(q, 32);
            const float rinv = 1.0f / sqrtf(q * (1.0f / 128.0f) + EPS);
            const size_t row = (size_t)(row0 + 32 * chalf + 16 * cb + lq);
            u32x2 ogc[8];
#pragma unroll
            for (int db = 0; db < 8; ++db) ogc[db] = ogw[db];
            if (cb == 0) {
#pragma unroll
                for (int db = 0; db < 8; ++db) ogw[db] = *(const u32x2*)((OG + (size_t)((PM == 2 ? cl_ * 64 : row0) + 32 * chalf) * 512 + h * 128) + ((lq * 512 + 4 * g) + (16 * 512 + 16 * db)));
            }
#pragma unroll
            for (int db = 0; db < 8; ++db) { const int dv = 16 * db + 4 * g;
                const f32x4 gn = *(const f32x4*)((F.gng + h * 128) + (4 * g + 16 * db));
                const u32x2 w0 = ogc[db];
                const f32x4 og = {bf2f((unsigned short)(w0.x & 0xffffu)), bf2f((unsigned short)(w0.x >> 16)), bf2f((unsigned short)(w0.y & 0xffffu)), bf2f((unsigned short)(w0.y >> 16))};
                const f32x4 o = O[db][cb] * rinv * gn * og; u32x2 w; w.x = cvtpk(o[0], o[1]); w.y = cvtpk(o[2], o[3]);
                *(u32x2*)((MIXW + (size_t)(row0 + 32 * chalf) * 1024 + 512 + h * 128) + ((lq * 1024 + 4 * g) + (16 * cb * 1024 + 16 * db))) = w; }
        }
        if (!has_next) break;
        p ^= 1;
        { int l2; asm volatile("v_mbcnt_lo_u32_b32 %0, -1, 0\n\tv_mbcnt_hi_u32_b32 %0, -1, %0" : "=v"(l2));
#pragma unroll
        for (int i = 0; i < 8; ++i) *(LAS u32x4*)(F.lds + G_VT + p * (4 * G_VT_HEAD) + (l2 >> 4) * G_VT_HEAD + (wave + 8 * i) * 288 + (l2 & 15) * 16) = vr[i]; }
        __syncthreads();
        ci = cn;
    }
    __syncthreads();
}
constexpr int N_PHASES = 9;
struct Args { const float* in[15]; float* out; unsigned char* ws; int ph_lo, ph_hi; };
static_assert(sizeof(Args) == 17 * 8 + 8, "Args has no padding");

__global__ void __launch_bounds__(NWAVES * 64, 2) fwd_kernel(Args args) {
    extern __shared__ __attribute__((aligned(16))) unsigned char lds[];
    Frame F;
    F.lds = (LAS unsigned char*)lds;
    F.MISC = (volatile LAS unsigned*)(F.lds + MISC_OFF);
    F.tid = threadIdx.x; F.lane = F.tid & 63; F.wave = __builtin_amdgcn_readfirstlane(F.tid >> 6);
#define FRESH_LANE() do { int l_; asm volatile("v_mbcnt_lo_u32_b32 %0, -1, 0\n\tv_mbcnt_hi_u32_b32 %0, -1, %0" : "=v"(l_)); F.lane = l_; } while (0)
    F.G = gridDim.x; F.ws = args.ws; F.out = args.out;
    F.xp = args.in[0]; F.xs = args.in[1]; F.g1 = args.in[2]; F.w_in = args.in[3]; F.upf = args.in[4]; F.bf_ = args.in[5]; F.upb = args.in[6]; F.bb = args.in[7];
    F.gng = args.in[8]; F.w_out = args.in[9]; F.g2 = args.in[10]; F.w_gate = args.in[11]; F.w_up = args.in[12]; F.w_down = args.in[13]; F.gfin = args.in[14];
    for (int u = F.tid; u < 64; u += NWAVES * 64) F.MISC[u] = 0u;
    __syncthreads();
    const int lo = args.ph_lo, hi = args.ph_hi;
    gu32* ctl = (gu32*)(F.ws + WS_CTL);
    XcdBarrier bar; bar.bar = (unsigned*)(ctl + CW_BAR); bar.x = 0; bar.st = nullptr;
    if (hi - lo > 1) bar = xcd_barrier_post((unsigned*)(ctl + CW_BAR), F.MISC + 8);
#define IN(k) (lo <= (k) && (k) < hi)
#define SEAM(k) do { if (IN(k) && IN((k) + 1)) xcd_barrier(bar); } while (0)

    if (IN(0)) { FRESH_LANE(); p0_prologue(F); } SEAM(0);

    if (IN(1)) {
        pg8::Gemm g{(const pg8::bf16_t*)(F.ws + WS_HN), (const pg8::bf16_t*)(F.ws + WS_WIN), MT, 3072, DM}; pg8::StaticOrder S; S.init(MT, 3072, F.G, (int)blockIdx.x);
        pg8::EpiInProj E{(pg8::bf16_t*)(F.ws + WS_MIX), (pg8::bf16_t*)(F.ws + WS_KA), (pg8::bf16_t*)(F.ws + WS_VA), (pg8::bf16_t*)(F.ws + WS_VG), (pg8::bf16_t*)(F.ws + WS_OG),
                         (const float*)(F.ws + WS_R0), (const float*)(F.ws + WS_ROPE), (const float*)(F.ws + WS_ROPE) + 8192 * 32};
        pg8::gemm_phase<pg8::EpiInProj, pg8::StaticOrder, true, true>(F.lds, g, S, E);
    } SEAM(1);

    if (IN(2)) {
        unsigned* ctlw = (unsigned*)(F.ws + WS_CTL);
        if ((int)blockIdx.x < TEAM_WGS) {
            FRESH_LANE(); gla_g1(F, (int)blockIdx.x, TEAM_WGS);
            team_barrier(ctlw + CW_TEAM, (unsigned)TEAM_WGS, ctlw + CW_BAR + 128);
            FRESH_LANE(); gla_g2(F, (int)blockIdx.x, TEAM_WGS);
            team_barrier(ctlw + CW_TEAM + 32, (unsigned)TEAM_WGS, ctlw + CW_BAR + 128);
            FRESH_LANE(); gla_g3<0>(F, ctlw + CW_GQ);
            FRESH_LANE(); attn_phase<0>(F, ctlw + CW_AQ);
        } else {
            FRESH_LANE(); attn_phase<0>(F, ctlw + CW_AQ);
            team_wait(ctlw + CW_TEAM + 32, (unsigned)TEAM_WGS, ctlw + CW_BAR + 128);
            FRESH_LANE(); gla_g3<0>(F, ctlw + CW_GQ);
        }
    } SEAM(2);

    if (IN(5)) {
        pg8::Gemm g{(const pg8::bf16_t*)(F.ws + WS_MIX), (const pg8::bf16_t*)(F.ws + WS_WOUT), MT, DM, DM}; pg8::StaticOrder S; S.init(MT, DM, F.G, (int)blockIdx.x);
        pg8::EpiOutProj E{(pg8::bf16_t*)(F.ws + WS_HN), (float*)(F.ws + WS_SS1)};
        pg8::gemm_phase<pg8::EpiOutProj, pg8::StaticOrder, true, true>(F.lds, g, S, E);
    } SEAM(5);

    if (IN(6)) {
        pg8::Gemm g{(const pg8::bf16_t*)(F.ws + WS_HN), (const pg8::bf16_t*)(F.ws + WS_WGU), MT, 2 * DFF, DM}; pg8::StaticOrder S; S.init(MT, 2 * DFF, F.G, (int)blockIdx.x);
        pg8::EpiFfn1 E{(pg8::bf16_t*)(F.ws + WS_H), (const float*)(F.ws + WS_SS1)};
        pg8::gemm_phase<pg8::EpiFfn1, pg8::StaticOrder, true, true>(F.lds, g, S, E);
    } SEAM(6);

    const bool fuse_final = (F.G == 256);
    if (IN(7) && !fuse_final) {
        pg8::Gemm g{(const pg8::bf16_t*)(F.ws + WS_H), (const pg8::bf16_t*)(F.ws + WS_WDN), MT, DM, DFF}; pg8::StaticOrder S; S.init(MT, DM, F.G, (int)blockIdx.x);
        pg8::EpiFfn2 E{(const pg8::bf16_t*)(F.ws + WS_HN), (pg8::bf16_t*)(F.ws + WS_MIX), (float*)(F.ws + WS_SS2)};
        pg8::gemm_phase<pg8::EpiFfn2, pg8::StaticOrder, true, true>(F.lds, g, S, E);
    }
    if (IN(7) && fuse_final) {
        pg8::Gemm g{(const pg8::bf16_t*)(F.ws + WS_H), (const pg8::bf16_t*)(F.ws + WS_WDN), MT, DM, DFF}; pg8::StaticOrder S; S.init(MT, DM, F.G, (int)blockIdx.x);
        pg8::EpiFfn2F E{(const pg8::bf16_t*)(F.ws + WS_HN), F.out, (float*)(F.ws + WS_SS2), (unsigned*)(F.ws + WS_CTL) + CW_MEET, (unsigned*)(F.ws + WS_CTL) + CW_BAR + 128, F.gfin};
        pg8::gemm_phase<pg8::EpiFfn2F, pg8::StaticOrder, true, true>(F.lds, g, S, E);
    }
    if (!fuse_final) { SEAM(7); if (IN(8)) { p8_final(F); } }
#undef IN
#undef FRESH_LANE
#undef SEAM
}

extern "C" void kernel_launch(void* const* d_in, const int* in_sizes, int n_in, void* d_out, int out_size, void* d_ws, size_t ws_size, hipStream_t stream) {
    static int grid = 0;
    if (grid == 0) {
        if (n_in != 15 || in_sizes[0] != MP * DM || in_sizes[1] != MS * DM || out_size != MT * DM || ws_size < WS_END) {
            fprintf(stderr, "kernel_launch: unexpected shapes (n_in %d, in0 %d, in1 %d, out %d, ws %zu); nothing launched\n", n_in, n_in > 0 ? in_sizes[0] : -1, n_in > 1 ? in_sizes[1] : -1, out_size, ws_size); grid = -1; return; }
        int dev = 0, cus = 0, per_cu = 0;
        if (hipGetDevice(&dev) != hipSuccess || hipDeviceGetAttribute(&cus, hipDeviceAttributeMultiprocessorCount, dev) != hipSuccess) { grid = -1; return; }
        if (hipFuncSetAttribute((const void*)fwd_kernel, hipFuncAttributeMaxDynamicSharedMemorySize, LDS_BYTES) != hipSuccess) { fprintf(stderr, "kernel_launch: hipFuncSetAttribute failed\n"); grid = -1; return; }
        if (hipOccupancyMaxActiveBlocksPerMultiprocessor(&per_cu, (const void*)fwd_kernel, NWAVES * 64, LDS_BYTES) != hipSuccess || per_cu < 1) { fprintf(stderr, "kernel_launch: occupancy query says %d blocks per CU\n", per_cu); per_cu = 1; }
        (void)hipGetLastError();
        grid = cus * 1;
        if (grid != 256) { fprintf(stderr, "kernel_launch: this build needs 256 compute units (found %d); nothing launched\n", cus); grid = -1; return; }
    }
    if (grid < 0) return;
    (void)hipMemsetAsync((char*)d_ws + WS_CTL, 0, CTL_ZERO_BYTES, stream);
    Args a{};
    for (int i = 0; i < 15; ++i) a.in[i] = (const float*)d_in[i];
    a.out = (float*)d_out; a.ws = (unsigned char*)d_ws;
#if MK_N_LAUNCHES == 1
    a.ph_lo = 0; a.ph_hi = N_PHASES;
    void* kargs[] = {&a};
    hipError_t e = hipLaunchCooperativeKernel((const void*)fwd_kernel, dim3(grid), dim3(NWAVES * 64), kargs, LDS_BYTES, stream);
    if (e != hipSuccess) fprintf(stderr, "kernel_launch: cooperative launch failed: %s (grid %d)\n", hipGetErrorString(e), grid);
#else
    for (int p = 0; p < N_PHASES; ++p) { a.ph_lo = p; a.ph_hi = p + 1; hipLaunchKernelGGL(fwd_kernel, dim3(grid), dim3(NWAVES * 64), LDS_BYTES, stream, a); }
#endif
}
```

```cpp
#include <hip/hip_runtime.h>
#include <hip/hip_bf16.h>
#include <cstdio>
#include <cstdint>
#include <cmath>

#ifndef MK_N_LAUNCHES
#define MK_N_LAUNCHES 1
#endif

constexpr int DM = 1024;
constexpr int MP = 4 * 4096;
constexpr int MS = 8 * 8192;
constexpr int MT = MP + MS;
constexpr int NIN = 3104, NINP = 3328;
constexpr int DFF = 2816;
constexpr int NCHUNK = MT / 64;
constexpr float EPS = 1e-6f;
constexpr float QSCALE = 0.125f * 1.4426950408889634f;

constexpr size_t MiB = 1u << 20;
constexpr size_t WS_CTL = 0, CTL_ZERO_BYTES = 64 * 1024;
constexpr size_t WS_SS1 = 128 * 1024, WS_SS2 = 512 * 1024;
constexpr size_t WS_WIN = 1 * MiB;
constexpr size_t WS_WOUT = 8 * MiB;
constexpr size_t WS_WGU = 10 * MiB;
constexpr size_t WS_WDN = 21 * MiB;
constexpr size_t WS_ROPE = 27 * MiB;
constexpr size_t WS_DECAY = 29 * MiB;
constexpr size_t WS_R0 = 31 * MiB + 512 * 1024;
constexpr size_t WS_MIX = 32 * MiB;
constexpr size_t WS_HN = 192 * MiB;
constexpr size_t WS_KA = 352 * MiB, WS_VA = 432 * MiB;
constexpr size_t WS_VG = 512 * MiB, WS_OG = 592 * MiB;
constexpr size_t WS_QE = 672 * MiB;
constexpr size_t WS_RFB = 832 * MiB;
constexpr size_t WS_KVT = 848 * MiB;
constexpr size_t WS_H = 352 * MiB;
constexpr size_t WS_END = 1008 * MiB;
constexpr size_t QE_STRIDE = (size_t)MT * 256;
static_assert(WS_H + (size_t)MT * DFF * 2 <= WS_RFB && WS_RFB + (size_t)MT * 32 * 4 <= WS_KVT && WS_KVT + (size_t)NCHUNK * 8 * 8192 * 2 <= WS_END, "ws map");
constexpr int CW_MEET = 1024;
constexpr int TEAM_WGS = 96;
constexpr int CW_TEAM = 2048, CW_AQ = 2112, CW_GQ = 2144;
constexpr int CW_BAR = 4096;

constexpr int LDS_BYTES = 163840;
constexpr int MISC_OFF = LDS_BYTES - 256;
constexpr int G_VT = 0, G_VT_HEAD = 64 * 288;
constexpr int G_KE = 4 * G_VT_HEAD;
constexpr int G_RF = G_KE + 8 * 9216;
constexpr int G_CL = G_RF + 8192;
static_assert(8 * G_VT_HEAD <= MISC_OFF, "lds map");
namespace pg8 {
#define PG8_LAS __attribute__((address_space(3)))
typedef unsigned short bf16_t;
typedef short bf16x8 __attribute__((ext_vector_type(8)));
typedef float f32x4 __attribute__((ext_vector_type(4)));
typedef unsigned u32x4 __attribute__((ext_vector_type(4)));
constexpr int BM = 256, BK = 64, HALF = 128, HTB = HALF * BK * 2  , STAGE_BYTES = 8 * HTB, NXCD = 8, WGM = 8;

__host__ __device__ __forceinline__ int lds_byte(int r, int c) { const int st = (r >> 4) * 2 + (c >> 5), rr = r & 15, cc = c & 31, ob = rr * 64 + cc * 2; return st * 1024 + (ob ^ (((ob >> 9) & 1) << 5)); }
__host__ __device__ __forceinline__ void stage_rc(int b, int& R, int& C) { const int st = b / 1024, sb = b % 1024, swz = sb ^ (((sb >> 9) & 1) << 5); R = (st >> 1) * 16 + swz / 64; C = (st & 1) * 32 + (swz % 64) / 2; }
__host__ __device__ __forceinline__ int perm32(int rho) { const int n = rho >> 4, i = rho & 15; return 8 * (i >> 2) + 4 * n + (i & 3); }

struct Unit { int pm, pn; };
struct Gemm { const bf16_t* A; const bf16_t* Bt; int M, N, K; };

struct StaticOrder {
    int nM, nN, nwg, G, c;
    __host__ __device__ void init(int M, int N, int G_, int c_) { nM = M / BM; nN = N / BM; nwg = nM * nN; G = G_; c = c_; }
    __host__ __device__ bool next(int i, Unit& u) const {
        const long L = (long)i * G + c; if (L >= nwg) return false;
        int wgid = (int)L; { const int q = nwg / NXCD, r = nwg % NXCD, xcd = wgid % NXCD, off = wgid / NXCD; wgid = (xcd < r ? xcd * (q + 1) : r * (q + 1) + (xcd - r) * q) + off; }
        const int nig = WGM * nN, gid = wgid / nig, fm = gid * WGM, gsz = (nM - fm) < WGM ? (nM - fm) : WGM;
        u.pm = fm + ((wgid % nig) % gsz); u.pn = (wgid % nig) / gsz; return true;
    }
    __device__ __forceinline__ void a_ready(const Unit&) const {}
    __device__ __forceinline__ void done(const Unit&) const {}
};

__device__ __forceinline__ unsigned cvt_pk_bf16(float lo, float hi) { unsigned r; asm volatile("v_cvt_pk_bf16_f32 %0, %1, %2" : "=v"(r) : "v"(lo), "v"(hi)); return r; }
typedef float f32x2 __attribute__((ext_vector_type(2)));
typedef unsigned u32x2 __attribute__((ext_vector_type(2)));
__device__ __forceinline__ float silu_f(float x) { return x * __builtin_amdgcn_rcpf(1.0f + __builtin_amdgcn_exp2f(-1.4426950408889634f * x)); }
__device__ __forceinline__ f32x4 silu4(f32x4 x) {
    const f32x4 t = x * (-1.4426950408889634f);
    f32x4 d = {__builtin_amdgcn_exp2f(t[0]), __builtin_amdgcn_exp2f(t[1]), __builtin_amdgcn_exp2f(t[2]), __builtin_amdgcn_exp2f(t[3])}; d = d + 1.0f;
    const f32x4 q = {__builtin_amdgcn_rcpf(d[0]), __builtin_amdgcn_rcpf(d[1]), __builtin_amdgcn_rcpf(d[2]), __builtin_amdgcn_rcpf(d[3])};
    return x * q;
}
__device__ __forceinline__ int seq_pos(int row) { return row < MP ? (row & 4095) : (row & 8191); }

struct EpiInProj {
    struct State { float rr[8]; };
    static constexpr bool PERM = true, AFTER_DRAIN = false, HAS_INIT = true;
    bf16_t* mix; bf16_t* ka; bf16_t* va; bf16_t* vg; bf16_t* og; const float* r0; const float* ropec; const float* ropes;
    __device__ __forceinline__ void init(f32x4 (&acc)[2][2][4][2], State& st, const Unit& u, int wr, int wc, int fr, int fq) const {
        const int row0 = u.pm * BM + wr * 64 + fr;
#pragma unroll
        for (int ai = 0; ai < 2; ++ai)
#pragma unroll
            for (int m = 0; m < 4; ++m) { st.rr[ai * 4 + m] = r0[row0 + ai * HALF + m * 16];
#pragma unroll
                for (int bj = 0; bj < 2; ++bj)
#pragma unroll
                    for (int n = 0; n < 2; ++n) acc[ai][bj][m][n] = (f32x4){0.f, 0.f, 0.f, 0.f}; }
    }
    __device__ __forceinline__ void operator()(const f32x4 (&acc)[2][2][4][2], const State& st, const Unit& u, int wr, int wc, int fr, int fq) const {
        const int pn = u.pn, row0 = u.pm * BM + wr * 64 + fr;
        if (pn < 4) {
            bf16_t* dst; int pitch; float sc;
            if (pn < 2) { dst = mix + pn * 256; pitch = 1024; sc = QSCALE; } else { dst = ka + (pn - 2) * 256; pitch = 512; sc = 1.0f; }
            const int d0 = 16 * (wc & 1) + 4 * fq;
#pragma unroll
            for (int ai = 0; ai < 2; ++ai) {
                f32x4 cs[4], sn[4];
#pragma unroll
                for (int m = 0; m < 4; ++m) { const int s = seq_pos(row0 + ai * HALF + m * 16);
                    cs[m] = *(const f32x4*)(ropec + s * 32 + d0); sn[m] = *(const f32x4*)(ropes + s * 32 + d0); }
#pragma unroll
                for (int m = 0; m < 4; ++m) {
                    const int row = row0 + ai * HALF + m * 16;
#pragma unroll
                    for (int bj = 0; bj < 2; ++bj) {
                        const f32x4 x1 = acc[ai][bj][m][0], x2 = acc[ai][bj][m][1];
                        const float scr = sc * st.rr[ai * 4 + m];
                        const f32x4 o1 = (x1 * cs[m] - x2 * sn[m]) * scr, o2 = (x2 * cs[m] + x1 * sn[m]) * scr;
                        bf16_t* p = dst + (size_t)row * pitch + 64 * (2 * bj + (wc >> 1)) + d0;
                        u32x2 w1, w2; w1.x = cvt_pk_bf16(o1[0], o1[1]); w1.y = cvt_pk_bf16(o1[2], o1[3]); w2.x = cvt_pk_bf16(o2[0], o2[1]); w2.y = cvt_pk_bf16(o2[2], o2[3]);
                        *(u32x2*)p = w1; *(u32x2*)(p + 32) = w2;
                    }
                }
            }
        } else {
            bf16_t* dst; int pitch; float sc = 1.0f; bool act = false;
            if (pn < 6) { dst = va + (pn - 4) * 256; pitch = 512; }
            else if (pn == 6) { dst = mix + 512; pitch = 1024; sc = 0.125f; }
            else if (pn == 7) { dst = mix + 768; pitch = 1024; }
            else if (pn < 10) { dst = vg + (pn - 8) * 256; pitch = 512; }
            else { dst = og + (pn - 10) * 256; pitch = 512; act = true; }
            const int col0 = wc * 32 + 8 * fq;
#pragma unroll
            for (int ai = 0; ai < 2; ++ai)
#pragma unroll
                for (int m = 0; m < 4; ++m) {
                    bf16_t* rowp = dst + (size_t)(row0 + ai * HALF + m * 16) * pitch + col0;
#pragma unroll
                    for (int bj = 0; bj < 2; ++bj) {
                        const float scr = sc * st.rr[ai * 4 + m];
                        f32x4 v0 = acc[ai][bj][m][0] * scr, v1 = acc[ai][bj][m][1] * scr;
                        if (act) { v0 = silu4(v0); v1 = silu4(v1); }
                        u32x4 w; w.x = cvt_pk_bf16(v0[0], v0[1]); w.y = cvt_pk_bf16(v0[2], v0[3]); w.z = cvt_pk_bf16(v1[0], v1[1]); w.w = cvt_pk_bf16(v1[2], v1[3]);
                        *(u32x4*)(rowp + bj * HALF) = w;
                    }
                }
        }
    }
};

struct EpiOutProj {
    struct State {};
    static constexpr bool PERM = true, AFTER_DRAIN = false, HAS_INIT = true;
    bf16_t* x1b; float* ss;
    __device__ __forceinline__ void init(f32x4 (&acc)[2][2][4][2], State& st, const Unit& u, int wr, int wc, int fr, int fq) const {
        const int row0 = u.pm * BM + wr * 64 + fr, col0 = u.pn * BM + wc * 32 + 8 * fq;
#pragma unroll
        for (int ai = 0; ai < 2; ++ai)
#pragma unroll
            for (int m = 0; m < 4; ++m) { const bf16_t* brow = x1b + (size_t)(row0 + ai * HALF + m * 16) * DM + col0;
#pragma unroll
                for (int bj = 0; bj < 2; ++bj) { const u32x4 w = *(const u32x4*)(brow + bj * HALF);
                    acc[ai][bj][m][0] = (f32x4){__uint_as_float(w.x << 16), __uint_as_float(w.x & 0xffff0000u), __uint_as_float(w.y << 16), __uint_as_float(w.y & 0xffff0000u)};
                    acc[ai][bj][m][1] = (f32x4){__uint_as_float(w.z << 16), __uint_as_float(w.z & 0xffff0000u), __uint_as_float(w.w << 16), __uint_as_float(w.w & 0xffff0000u)}; } }
    }
    __device__ __forceinline__ void operator()(const f32x4 (&acc)[2][2][4][2], const State& st, const Unit& u, int wr, int wc, int fr, int fq) const {
        const int row0 = u.pm * BM + wr * 64 + fr, col0 = u.pn * BM + wc * 32 + 8 * fq;
#pragma unroll
        for (int ai = 0; ai < 2; ++ai)
#pragma unroll
            for (int m = 0; m < 4; ++m) {
                const int row = row0 + ai * HALF + m * 16;
                bf16_t* brow = x1b + (size_t)row * DM + col0;
                f32x4 q4 = {0.f, 0.f, 0.f, 0.f};
#pragma unroll
                for (int bj = 0; bj < 2; ++bj) {
                    const f32x4 v0 = acc[ai][bj][m][0], v1 = acc[ai][bj][m][1];
                    u32x4 w; w.x = cvt_pk_bf16(v0[0], v0[1]); w.y = cvt_pk_bf16(v0[2], v0[3]); w.z = cvt_pk_bf16(v1[0], v1[1]); w.w = cvt_pk_bf16(v1[2], v1[3]);
                    *(u32x4*)(brow + bj * HALF) = w;
                    q4 = q4 + v0 * v0 + v1 * v1;
                }
                float q = (q4[0] + q4[1]) + (q4[2] + q4[3]);
                q += __shfl_xor(q, 16); q += __shfl_xor(q, 32);
                if (fq == 0) atomicAdd(ss + row, q);
            }
    }
};

template <int MODE> struct EpiFfn1T {
    struct State { float ssv[8]; };
    static constexpr bool PERM = true, AFTER_DRAIN = false, HAS_INIT = true;
    bf16_t* h; const float* ss;
    __device__ __forceinline__ void init(f32x4 (&acc)[2][2][4][2], State& st, const Unit& u, int wr, int wc, int fr, int fq) const {
        const int row0 = u.pm * BM + wr * 64 + fr;
#pragma unroll
        for (int ai = 0; ai < 2; ++ai)
#pragma unroll
            for (int m = 0; m < 4; ++m) { st.ssv[ai * 4 + m] = __hip_atomic_load(ss + row0 + ai * HALF + m * 16, __ATOMIC_RELAXED, __HIP_MEMORY_SCOPE_AGENT);
#pragma unroll
                for (int bj = 0; bj < 2; ++bj)
#pragma unroll
                    for (int n = 0; n < 2; ++n) acc[ai][bj][m][n] = (f32x4){0.f, 0.f, 0.f, 0.f}; }
    }
    __device__ __forceinline__ void operator()(const f32x4 (&acc)[2][2][4][2], const State& st, const Unit& u, int wr, int wc, int fr, int fq) const {
        const int row0 = u.pm * BM + wr * 64 + fr, col0 = u.pn * HALF + wc * 32 + 8 * fq;
        if (MODE == 1) {
#pragma unroll
            for (int ai = 0; ai < 2; ++ai)
#pragma unroll
                for (int m = 0; m < 4; ++m)
#pragma unroll
                    for (int bj = 0; bj < 2; ++bj)
#pragma unroll
                        for (int n = 0; n < 2; ++n) asm volatile("" :: "v"(acc[ai][bj][m][n]));
            return; }
#pragma unroll
        for (int ai = 0; ai < 2; ++ai)
#pragma unroll
            for (int m = 0; m < 4; ++m) {
                const int row = row0 + ai * HALF + m * 16;
                const float r = __builtin_amdgcn_rsqf(st.ssv[ai * 4 + m] * (1.0f / DM) + EPS);
                const f32x2 r2 = {r, r};
                unsigned wv[4];
#pragma unroll
                for (int n = 0; n < 2; ++n)
#pragma unroll
                    for (int p = 0; p < 2; ++p) {
                        const f32x2 a = (f32x2){acc[ai][0][m][n][2 * p], acc[ai][0][m][n][2 * p + 1]} * r2, b = (f32x2){acc[ai][1][m][n][2 * p], acc[ai][1][m][n][2 * p + 1]} * r2;
                        const f32x2 t = a * (-1.4426950408889634f);
                        f32x2 d; d.x = __builtin_amdgcn_exp2f(t.x); d.y = __builtin_amdgcn_exp2f(t.y); d = d + 1.0f;
                        f32x2 q; q.x = __builtin_amdgcn_rcpf(d.x); q.y = __builtin_amdgcn_rcpf(d.y);
                        const f32x2 o = (a * b) * q;
                        wv[2 * n + p] = cvt_pk_bf16(o.x, o.y);
                    }
                u32x4 w; w.x = wv[0]; w.y = wv[1]; w.z = wv[2]; w.w = wv[3];
                *(u32x4*)(h + (size_t)row * DFF + col0) = w;
            }
    }
};

typedef EpiFfn1T<0> EpiFfn1;

struct EpiFfn2 {
    struct State {};
    static constexpr bool PERM = true, AFTER_DRAIN = false, HAS_INIT = true;
    const bf16_t* x1b; bf16_t* x2b; float* ss;
    __device__ __forceinline__ void init(f32x4 (&acc)[2][2][4][2], State& st, const Unit& u, int wr, int wc, int fr, int fq) const {
        const int row0 = u.pm * BM + wr * 64 + fr, col0 = u.pn * BM + wc * 32 + 8 * fq;
#pragma unroll
        for (int ai = 0; ai < 2; ++ai)
#pragma unroll
            for (int m = 0; m < 4; ++m) { const bf16_t* brow = x1b + (size_t)(row0 + ai * HALF + m * 16) * DM + col0;
#pragma unroll
                for (int bj = 0; bj < 2; ++bj) { const u32x4 w = *(const u32x4*)(brow + bj * HALF);
                    acc[ai][bj][m][0] = (f32x4){__uint_as_float(w.x << 16), __uint_as_float(w.x & 0xffff0000u), __uint_as_float(w.y << 16), __uint_as_float(w.y & 0xffff0000u)};
                    acc[ai][bj][m][1] = (f32x4){__uint_as_float(w.z << 16), __uint_as_float(w.z & 0xffff0000u), __uint_as_float(w.w << 16), __uint_as_float(w.w & 0xffff0000u)}; } }
    }
    __device__ __forceinline__ void operator()(const f32x4 (&acc)[2][2][4][2], const State& st, const Unit& u, int wr, int wc, int fr, int fq) const {
        const int row0 = u.pm * BM + wr * 64 + fr, col0 = u.pn * BM + wc * 32 + 8 * fq;
#pragma unroll
        for (int ai = 0; ai < 2; ++ai)
#pragma unroll
            for (int m = 0; m < 4; ++m) {
                const int row = row0 + ai * HALF + m * 16;
                bf16_t* brow = x2b + (size_t)row * DM + col0;
                f32x4 q4 = {0.f, 0.f, 0.f, 0.f};
#pragma unroll
                for (int bj = 0; bj < 2; ++bj) {
                    const f32x4 v0 = acc[ai][bj][m][0], v1 = acc[ai][bj][m][1];
                    u32x4 w; w.x = cvt_pk_bf16(v0[0], v0[1]); w.y = cvt_pk_bf16(v0[2], v0[3]); w.z = cvt_pk_bf16(v1[0], v1[1]); w.w = cvt_pk_bf16(v1[2], v1[3]);
                    *(u32x4*)(brow + bj * HALF) = w;
                    q4 = q4 + v0 * v0 + v1 * v1;
                }
                float q = (q4[0] + q4[1]) + (q4[2] + q4[3]);
                q += __shfl_xor(q, 16); q += __shfl_xor(q, 32);
                if (fq == 0) atomicAdd(ss + row, q);
            }
    }
};

struct EpiFfn2F {
    struct State {};
    static constexpr bool PERM = true, AFTER_DRAIN = false, HAS_INIT = true;
    const bf16_t* x1b; float* out; float* ss; unsigned* cnt; unsigned* tmo; const float* gf;
    __device__ __forceinline__ void init(f32x4 (&acc)[2][2][4][2], State& st, const Unit& u, int wr, int wc, int fr, int fq) const {
        const int row0 = u.pm * BM + wr * 64 + fr, col0 = u.pn * BM + wc * 32 + 8 * fq;
#pragma unroll
        for (int ai = 0; ai < 2; ++ai)
#pragma unroll
            for (int m = 0; m < 4; ++m) { const bf16_t* brow = x1b + (size_t)(row0 + ai * HALF + m * 16) * DM + col0;
#pragma unroll
                for (int bj = 0; bj < 2; ++bj) { const u32x4 w = *(const u32x4*)(brow + bj * HALF);
                    acc[ai][bj][m][0] = (f32x4){__uint_as_float(w.x << 16), __uint_as_float(w.x & 0xffff0000u), __uint_as_float(w.y << 16), __uint_as_float(w.y & 0xffff0000u)};
                    acc[ai][bj][m][1] = (f32x4){__uint_as_float(w.z << 16), __uint_as_float(w.z & 0xffff0000u), __uint_as_float(w.w << 16), __uint_as_float(w.w & 0xffff0000u)}; } }
    }
    __device__ __forceinline__ void operator()(const f32x4 (&acc)[2][2][4][2], const State& st, const Unit& u, int wr, int wc, int fr, int fq) const {
        const int row0 = u.pm * BM + wr * 64 + fr, col0 = u.pn * BM + wc * 32 + 8 * fq;
#pragma unroll
        for (int ai = 0; ai < 2; ++ai)
#pragma unroll
            for (int m = 0; m < 4; ++m) {
                f32x4 q4 = {0.f, 0.f, 0.f, 0.f};
#pragma unroll
                for (int bj = 0; bj < 2; ++bj) { const f32x4 v0 = acc[ai][bj][m][0], v1 = acc[ai][bj][m][1]; q4 = q4 + v0 * v0 + v1 * v1; }
                float q = (q4[0] + q4[1]) + (q4[2] + q4[3]);
                q += __shfl_xor(q, 16); q += __shfl_xor(q, 32);
                if (fq == 0) (void)__hip_atomic_fetch_add(ss + row0 + ai * HALF + m * 16, q, __ATOMIC_RELAXED, __HIP_MEMORY_SCOPE_AGENT);
            }
        asm volatile("s_waitcnt vmcnt(0)" ::: "memory");
        __syncthreads();
        if (threadIdx.x == 0) {
            (void)__hip_atomic_fetch_add(cnt + u.pm, 1u, __ATOMIC_RELAXED, __HIP_MEMORY_SCOPE_AGENT);
            unsigned sp = 0u;
            while (__hip_atomic_load(cnt + u.pm, __ATOMIC_RELAXED, __HIP_MEMORY_SCOPE_AGENT) < 4u) { __builtin_amdgcn_s_sleep(1);
                if ((++sp & 255u) == 0u) { if (__hip_atomic_load(tmo, __ATOMIC_RELAXED, __HIP_MEMORY_SCOPE_AGENT)) break; if (sp > (1u << 18)) { atomicAdd(tmo, 1u); break; } } }
        }
        __syncthreads();
        f32x4 g4[2][2];
#pragma unroll
        for (int bj = 0; bj < 2; ++bj) { g4[bj][0] = *(const f32x4*)(gf + col0 + bj * HALF); g4[bj][1] = *(const f32x4*)(gf + col0 + bj * HALF + 4); }
        float rr[2][4];
#pragma unroll
        for (int ai = 0; ai < 2; ++ai)
#pragma unroll
            for (int m = 0; m < 4; ++m) rr[ai][m] = __hip_atomic_load(ss + row0 + ai * HALF + m * 16, __ATOMIC_RELAXED, __HIP_MEMORY_SCOPE_AGENT);
#pragma unroll
        for (int ai = 0; ai < 2; ++ai)
#pragma unroll
            for (int m = 0; m < 4; ++m) {
                const float r = 1.0f / sqrtf(rr[ai][m] * (1.0f / DM) + EPS);
                float* orow = out + (size_t)(row0 + ai * HALF + m * 16) * DM + col0;
#pragma unroll
                for (int bj = 0; bj < 2; ++bj) { *(f32x4*)(orow + bj * HALF) = acc[ai][bj][m][0] * r * g4[bj][0]; *(f32x4*)(orow + bj * HALF + 4) = acc[ai][bj][m][1] * r * g4[bj][1]; }
            }
    }
};

template <class Epi, class Sched, bool ALIGN_EPI = false, bool SP2 = false>
__device__ __forceinline__ void gemm_phase(PG8_LAS unsigned char* lds, const Gemm g, const Sched& S, const Epi& E) {
    const int tid = threadIdx.x, wid = __builtin_amdgcn_readfirstlane(tid >> 6), lane = tid & 63, wr = wid >> 2, wc = wid & 3, fr = lane & 15, fq = lane >> 4;
    const int K = g.K, nt = K / BK;
    unsigned voffA[2], voffB[2];
#pragma unroll
    for (int i = 0; i < 2; ++i) { int R, C; stage_rc(tid * 16 + i * 8192, R, C); const int Rb = Epi::PERM ? ((R & ~31) + perm32(R & 31)) : R;
        voffA[i] = (unsigned)(R * K + C) * 2u; voffB[i] = (unsigned)(Rb * K + C) * 2u; }
    const size_t kstep = (size_t)(BK * 2);
    const size_t hstep = (size_t)HALF * K * 2;
    const size_t tstep = 2 * hstep;
    const unsigned ldsw = (unsigned)wid * 1024u;
    const int aoff = lds_byte(wr * 64 + fr, fq * 8), boff = lds_byte(wc * 32 + fr, fq * 8);
#define PG8_SA(b, h) (((b) * 2 + (h)) * HTB)
#define PG8_SB(b, h) ((4 + (b) * 2 + (h)) * HTB)
#define PG8_STAGE(bufoff, gbase, voff) do { _Pragma("unroll") for (int _i = 0; _i < 2; ++_i) \
        __builtin_amdgcn_global_load_lds((const unsigned*)((const char*)(gbase) + (voff)[_i]), (PG8_LAS unsigned*)(lds + (bufoff) + ldsw + _i * 8192), 16, 0, 0); } while (0)
#define PG8_LDA(dst, b, h) do { _Pragma("unroll") for (int m = 0; m < 4; ++m) _Pragma("unroll") for (int k = 0; k < 2; ++k) dst[m][k] = *(const PG8_LAS bf16x8*)(lds + PG8_SA(b, h) + aoff + m * 2048 + k * 1024); } while (0)
#define PG8_LDB(dst, b, h) do { _Pragma("unroll") for (int n = 0; n < 2; ++n) _Pragma("unroll") for (int k = 0; k < 2; ++k) dst[n][k] = *(const PG8_LAS bf16x8*)(lds + PG8_SB(b, h) + boff + n * 2048 + k * 1024); } while (0)
#define PG8_MMA(ai, bj, At, Bt) do { __builtin_amdgcn_s_setprio(1); _Pragma("unroll") for (int m = 0; m < 4; ++m) _Pragma("unroll") for (int n = 0; n < 2; ++n) _Pragma("unroll") for (int k = 0; k < 2; ++k) \
        acc[ai][bj][m][n] = __builtin_amdgcn_mfma_f32_16x16x32_bf16(Bt[n][k], At[m][k], acc[ai][bj][m][n], 0, 0, 0); __builtin_amdgcn_s_setprio(0); } while (0)
#define PG8_WAIT_V(n) asm volatile("s_waitcnt vmcnt(" #n ")" ::: "memory")
#define PG8_WAIT_L(n) asm volatile("s_waitcnt lgkmcnt(" #n ")" ::: "memory")
#define PG8_BAR __builtin_amdgcn_s_barrier()
#define PG8_SCHED __builtin_amdgcn_sched_barrier(0)
    Unit cur, nxt; int ui = 0;
    if (!S.next(0, cur)) return;
    f32x4 acc[2][2][4][2]; typename Epi::State est;
    if constexpr (Epi::HAS_INIT) E.init(acc, est, cur, wr, wc, fr, fq);
    else {
#pragma unroll
    for (int a = 0; a < 2; ++a)
#pragma unroll
        for (int b = 0; b < 2; ++b)
#pragma unroll
            for (int m = 0; m < 4; ++m)
#pragma unroll
                for (int n = 0; n < 2; ++n) acc[a][b][m][n] = (f32x4){0.f, 0.f, 0.f, 0.f};
    }
    bf16x8 At[4][2], B0[2][2], B1[2][2];
    const char* cA = (const char*)g.A + (size_t)cur.pm * tstep; const char* cB = (const char*)g.Bt + (size_t)cur.pn * tstep;
    S.a_ready(cur);
    if constexpr (SP2) {
        PG8_STAGE(PG8_SB(0, 0), cB, voffB); PG8_STAGE(PG8_SB(0, 1), cB + hstep, voffB); PG8_STAGE(PG8_SA(0, 0), cA, voffA); PG8_STAGE(PG8_SA(0, 1), cA + hstep, voffA);
        if (wr == 1) PG8_BAR;
        PG8_WAIT_V(2); PG8_BAR;
        PG8_STAGE(PG8_SB(1, 0), cB + kstep, voffB); PG8_STAGE(PG8_SA(1, 0), cA + kstep, voffA); PG8_STAGE(PG8_SB(1, 1), cB + hstep + kstep, voffB);
        PG8_WAIT_V(6); PG8_BAR;
    } else {
        PG8_STAGE(PG8_SB(0, 0), cB, voffB); PG8_STAGE(PG8_SA(0, 0), cA, voffA); PG8_STAGE(PG8_SB(0, 1), cB + hstep, voffB); PG8_STAGE(PG8_SA(0, 1), cA + hstep, voffA);
        if (wr == 1) PG8_BAR;
        PG8_WAIT_V(4); PG8_BAR;
        PG8_STAGE(PG8_SB(1, 0), cB + kstep, voffB); PG8_STAGE(PG8_SA(1, 0), cA + kstep, voffA); PG8_STAGE(PG8_SB(1, 1), cB + hstep + kstep, voffB);
        PG8_WAIT_V(6); PG8_BAR;
    }
    for (;;) {
        const bool has_next = S.next(ui + 1, nxt);
        const char* nA = has_next ? (const char*)g.A + (size_t)nxt.pm * tstep : cA; const char* nB = has_next ? (const char*)g.Bt + (size_t)nxt.pn * tstep : cB;
        for (int t = 0; t < nt; t += 2) {
            const bool last = (t == nt - 2);
            const char* a1 = cA + (size_t)(t + 1) * kstep;
            const char* a2 = last ? nA : cA + (size_t)(t + 2) * kstep; const char* b2 = last ? nB : cB + (size_t)(t + 2) * kstep;
            const char* a3 = a2 + kstep; const char* b3 = b2 + kstep;
            if (last && has_next) S.a_ready(nxt);
            if constexpr (SP2) {
            PG8_LDB(B0, 0, 0); PG8_LDB(B1, 0, 1); PG8_SCHED; PG8_LDA(At, 0, 0); PG8_STAGE(PG8_SA(1, 1), a1 + hstep, voffA);
            PG8_WAIT_V(8); PG8_WAIT_L(0); PG8_BAR; PG8_MMA(0, 0, At, B0); PG8_MMA(0, 1, At, B1); PG8_BAR; PG8_SCHED;
            PG8_LDA(At, 0, 1); PG8_STAGE(PG8_SB(0, 0), b2, voffB); PG8_STAGE(PG8_SB(0, 1), b2 + hstep, voffB); PG8_STAGE(PG8_SA(0, 0), a2, voffA);
            PG8_WAIT_V(8); PG8_WAIT_L(0); PG8_BAR; PG8_MMA(1, 0, At, B0); PG8_MMA(1, 1, At, B1); PG8_BAR; PG8_SCHED;
            PG8_LDB(B0, 1, 0); PG8_LDB(B1, 1, 1); PG8_SCHED; PG8_LDA(At, 1, 0); PG8_STAGE(PG8_SA(0, 1), a2 + hstep, voffA);
            PG8_WAIT_V(8); PG8_WAIT_L(0); PG8_BAR; PG8_MMA(0, 0, At, B0); PG8_MMA(0, 1, At, B1); PG8_BAR; PG8_SCHED;
            PG8_LDA(At, 1, 1); PG8_STAGE(PG8_SB(1, 0), b3, voffB); PG8_STAGE(PG8_SB(1, 1), b3 + hstep, voffB); PG8_STAGE(PG8_SA(1, 0), a3, voffA);
            PG8_WAIT_V(8); PG8_WAIT_L(0); PG8_BAR; PG8_MMA(1, 0, At, B0); PG8_MMA(1, 1, At, B1); PG8_BAR; PG8_SCHED;
            } else {
            PG8_LDB(B0, 0, 0); PG8_SCHED; PG8_LDA(At, 0, 0); PG8_STAGE(PG8_SA(1, 1), a1 + hstep, voffA);
            PG8_WAIT_L(8); PG8_BAR; PG8_WAIT_L(0); PG8_MMA(0, 0, At, B0); PG8_BAR; PG8_SCHED;
            PG8_LDB(B1, 0, 1); PG8_STAGE(PG8_SB(0, 0), b2, voffB);
            PG8_BAR; PG8_WAIT_L(0); PG8_MMA(0, 1, At, B1); PG8_BAR;
            PG8_LDA(At, 0, 1); PG8_STAGE(PG8_SA(0, 0), a2, voffA);
            PG8_BAR; PG8_WAIT_L(0); PG8_MMA(1, 0, At, B0); PG8_BAR; PG8_SCHED;
            PG8_STAGE(PG8_SB(0, 1), b2 + hstep, voffB);
            PG8_WAIT_V(6); PG8_BAR; PG8_MMA(1, 1, At, B1); PG8_BAR;
            PG8_LDB(B0, 1, 0); PG8_SCHED; PG8_LDA(At, 1, 0); PG8_STAGE(PG8_SA(0, 1), a2 + hstep, voffA);
            PG8_WAIT_L(8); PG8_BAR; PG8_WAIT_L(0); PG8_MMA(0, 0, At, B0); PG8_BAR; PG8_SCHED;
            PG8_LDB(B1, 1, 1); PG8_STAGE(PG8_SB(1, 0), b3, voffB);
            PG8_BAR; PG8_WAIT_L(0); PG8_MMA(0, 1, At, B1); PG8_BAR;
            PG8_LDA(At, 1, 1); PG8_STAGE(PG8_SA(1, 0), a3, voffA);
            PG8_BAR; PG8_WAIT_L(0); PG8_MMA(1, 0, At, B0); PG8_BAR; PG8_SCHED;
            PG8_STAGE(PG8_SB(1, 1), b3 + hstep, voffB);
            PG8_WAIT_V(6); PG8_BAR; PG8_MMA(1, 1, At, B1); PG8_BAR;
            }
        }
        if constexpr (ALIGN_EPI) { if (wr == 0) PG8_BAR; }
        if constexpr (!Epi::AFTER_DRAIN) { E(acc, est, cur, wr, wc, fr, fq); S.done(cur); }
        if (!has_next) break;
        if constexpr (Epi::HAS_INIT) E.init(acc, est, nxt, wr, wc, fr, fq);
        else {
#pragma unroll
        for (int a = 0; a < 2; ++a)
#pragma unroll
            for (int b = 0; b < 2; ++b)
#pragma unroll
                for (int m = 0; m < 4; ++m)
#pragma unroll
                    for (int n = 0; n < 2; ++n) acc[a][b][m][n] = (f32x4){0.f, 0.f, 0.f, 0.f};
        }
        cur = nxt; cA = nA; cB = nB; ++ui;
        if constexpr (ALIGN_EPI) { if (wr == 1) PG8_BAR; }
    }
    PG8_WAIT_V(0);
    if constexpr (!ALIGN_EPI) { if (wr == 0) PG8_BAR; }
    PG8_BAR;
    if constexpr (Epi::AFTER_DRAIN) { E.fused(acc, cur, wr, wc, fr, fq, lds, wid, lane); S.done(cur); }
#undef PG8_SA
#undef PG8_SB
#undef PG8_STAGE
#undef PG8_LDA
#undef PG8_LDB
#undef PG8_MMA
#undef PG8_WAIT_V
#undef PG8_WAIT_L
#undef PG8_BAR
#undef PG8_SCHED
}
}
#define GAS __attribute__((address_space(1)))
#define LAS __attribute__((address_space(3)))
typedef unsigned short bf16;
typedef unsigned v4u __attribute__((ext_vector_type(4)));
typedef float f32x4 __attribute__((ext_vector_type(4)));
typedef short bf16x8 __attribute__((ext_vector_type(8)));
typedef GAS unsigned gu32;
typedef GAS unsigned long long gu64;
#define RLX_AGENT __ATOMIC_RELAXED, __HIP_MEMORY_SCOPE_AGENT
#define LDS_WAIT() asm volatile("s_waitcnt lgkmcnt(0)" ::: "memory")
#define VM_WAIT() asm volatile("s_waitcnt vmcnt(0)" ::: "memory")
__device__ __forceinline__ unsigned long long rt() { return __builtin_amdgcn_s_memrealtime(); }
__device__ __forceinline__ unsigned f2bf(float f) { unsigned u = __builtin_bit_cast(unsigned, f); return (u + 0x7fffu + ((u >> 16) & 1u)) >> 16; }
__device__ __forceinline__ unsigned pk2(float lo, float hi) { return f2bf(lo) | (f2bf(hi) << 16); }

#define XB_TMO      128
#define XB_XCNT(j)  (256  + 64 * (j))
#define XB_XSUB(j)  (1280 + 64 * (j))
#define XB_XGEN(j)  (2304 + 64 * (j))
#define XB_TOP      3328
#define XB_TOPGEN   3392
#define XCD_BAR_WORDS 3456
#define XB_SPIN_CAP (1u << 18)

__device__ __forceinline__ unsigned xb_ld(unsigned* p)              { return __hip_atomic_load(p, __ATOMIC_RELAXED, __HIP_MEMORY_SCOPE_AGENT); }
__device__ __forceinline__ unsigned xb_add(unsigned* p, unsigned v) { return __hip_atomic_fetch_add(p, v, __ATOMIC_RELAXED, __HIP_MEMORY_SCOPE_AGENT); }
__device__ __forceinline__ unsigned xb_xcc_id() { return (unsigned)__builtin_amdgcn_s_getreg((3 << 11) | 20) & 0xFu; }
#define XB_SPIN(cond, bar) do { unsigned _sp = 0; while (cond) { __builtin_amdgcn_s_sleep(1); \
    if ((++_sp & 255u) == 0u) { if (xb_ld(&(bar)[XB_TMO])) break; if (_sp > XB_SPIN_CAP) { atomicAdd(&(bar)[XB_TMO], 1u); break; } } } } while (0)

struct XcdBarrier {
    unsigned* bar; unsigned x;
    volatile LAS unsigned* st;
};

__device__ __forceinline__ XcdBarrier xcd_barrier_post(unsigned* bar, volatile LAS unsigned* st) {
    XcdBarrier b; b.bar = bar; b.x = xb_xcc_id(); b.st = st;
    if (threadIdx.x == 0) (void)xb_add(&bar[XB_XCNT(b.x)], 1u);
    return b;
}
__device__ __forceinline__ void xcd_barrier_complete(unsigned* bar, unsigned x, unsigned& nloc, unsigned& nx) {
    const unsigned G = gridDim.x * gridDim.y * gridDim.z;
    unsigned sum, cnt, mine, sp = 0u;
    for (;;) {
        sum = 0u; cnt = 0u; mine = 0u;
#pragma unroll
        for (unsigned j = 0; j < 16; ++j) { const unsigned c = xb_ld(&bar[XB_XCNT(j)]); sum += c; cnt += (c > 0u) ? 1u : 0u; mine = (j == x) ? c : mine; }
        if (sum == G) break;
        __builtin_amdgcn_s_sleep(1);
        if ((++sp & 255u) == 0u) { if (xb_ld(&bar[XB_TMO])) break; if (sp > XB_SPIN_CAP) { atomicAdd(&bar[XB_TMO], 1u); break; } }
    }
    nloc = mine > 0u ? mine : 1u; nx = cnt > 0u ? cnt : 1u;
}

__device__ __forceinline__ void xcd_barrier(const XcdBarrier& b) {
    asm volatile("s_waitcnt vmcnt(0)" ::: "memory");
    __syncthreads();
    if (threadIdx.x == 0) {
        unsigned* bar = b.bar;
        __builtin_amdgcn_s_waitcnt(0);
        unsigned nloc = b.st[0], nx = b.st[1];
        if (nloc == 0u) { xcd_barrier_complete(bar, b.x, nloc, nx); b.st[0] = nloc; b.st[1] = nx; }
        const unsigned old = xb_add(&bar[XB_XSUB(b.x)], 1u);
        const unsigned gen = old / nloc;
        if (old + 1u == (gen + 1u) * nloc) {
            __builtin_amdgcn_fence(__ATOMIC_RELEASE, "agent");
            asm volatile("s_waitcnt vmcnt(0)" ::: "memory");
            const unsigned og = xb_add(&bar[XB_TOP], 1u);
            const unsigned tg = og / nx;
            if (og + 1u == (tg + 1u) * nx) xb_add(&bar[XB_TOPGEN], 1u);
            else XB_SPIN(xb_ld(&bar[XB_TOPGEN]) == tg, bar);
            __builtin_amdgcn_fence(__ATOMIC_ACQUIRE, "agent");
            xb_add(&bar[XB_XGEN(b.x)], 1u);
            asm volatile("s_waitcnt vmcnt(0)" ::: "memory");
        } else {
            XB_SPIN(xb_ld(&bar[XB_XGEN(b.x)]) == gen, bar);
            __builtin_amdgcn_fence(__ATOMIC_ACQUIRE, "agent");
            asm volatile("s_waitcnt vmcnt(0)" ::: "memory");
        }
    }
    __syncthreads();
}

__device__ __forceinline__ void team_barrier(unsigned* cnt, unsigned expected, unsigned* tmo) {
    asm volatile("s_waitcnt vmcnt(0)" ::: "memory");
    __syncthreads();
    if (threadIdx.x == 0) {
        __builtin_amdgcn_fence(__ATOMIC_RELEASE, "agent");
        asm volatile("s_waitcnt vmcnt(0)" ::: "memory");
        (void)xb_add(cnt, 1u);
        unsigned sp = 0u;
        while (xb_ld(cnt) < expected) { __builtin_amdgcn_s_sleep(2); if ((++sp & 255u) == 0u) { if (xb_ld(tmo)) break; if (sp > XB_SPIN_CAP) { atomicAdd(tmo, 1u); break; } } }
        __builtin_amdgcn_fence(__ATOMIC_ACQUIRE, "agent");
        asm volatile("s_waitcnt vmcnt(0)" ::: "memory");
    }
    __syncthreads();
}

__device__ __forceinline__ void team_wait(unsigned* cnt, unsigned expected, unsigned* tmo) {
    if (threadIdx.x == 0) {
        unsigned sp = 0u;
        while (xb_ld(cnt) < expected) { __builtin_amdgcn_s_sleep(8); if ((++sp & 255u) == 0u) { if (xb_ld(tmo)) break; if (sp > XB_SPIN_CAP) { atomicAdd(tmo, 1u); break; } } }
        __builtin_amdgcn_fence(__ATOMIC_ACQUIRE, "agent");
        asm volatile("s_waitcnt vmcnt(0)" ::: "memory");
    }
    __syncthreads();
}
constexpr int NWAVES = 8;
typedef short v4i16_t __attribute__((ext_vector_type(4)));
typedef unsigned u32x2 __attribute__((ext_vector_type(2)));
typedef float f32x2v __attribute__((ext_vector_type(2)));
typedef __bf16 bf16x2_t __attribute__((ext_vector_type(2)));
typedef unsigned u32x4 __attribute__((ext_vector_type(4)));
__device__ __forceinline__ unsigned cvtpk(float lo, float hi) { f32x2v v = {lo, hi}; bf16x2_t b = __builtin_convertvector(v, bf16x2_t); return __builtin_bit_cast(unsigned, b); }
__device__ __forceinline__ float bf2f(unsigned short u) { return __uint_as_float((unsigned)u << 16); }
__device__ __forceinline__ unsigned short f2bf16(float f) { return (unsigned short)(cvtpk(f, 0.f) & 0xffffu); }
__device__ __forceinline__ v4i16_t ldtr(LAS unsigned char* p) { return __builtin_amdgcn_ds_read_tr16_b64_v4i16((LAS v4i16_t*)p); }
__device__ __forceinline__ bf16x8 cat8(v4i16_t a, v4i16_t b) { return (bf16x8){a[0], a[1], a[2], a[3], b[0], b[1], b[2], b[3]}; }
__device__ __forceinline__ bf16x8 pack8(f32x4 a, f32x4 b) { u32x4 w; w.x = cvtpk(a[0], a[1]); w.y = cvtpk(a[2], a[3]); w.z = cvtpk(b[0], b[1]); w.w = cvtpk(b[2], b[3]); return __builtin_bit_cast(bf16x8, w); }
#define MFMA16(a, b, c) __builtin_amdgcn_mfma_f32_16x16x32_bf16((a), (b), (c), 0, 0, 0)

__device__ __forceinline__ float red4_max(float x) {
    auto a = __builtin_amdgcn_permlane16_swap(__float_as_uint(x), __float_as_uint(x), false, false); x = fmaxf(__uint_as_float(a[0]), __uint_as_float(a[1]));
    auto b = __builtin_amdgcn_permlane32_swap(__float_as_uint(x), __float_as_uint(x), false, false); return fmaxf(__uint_as_float(b[0]), __uint_as_float(b[1]));
}
__device__ __forceinline__ float red4_sum(float x) {
    auto a = __builtin_amdgcn_permlane16_swap(__float_as_uint(x), __float_as_uint(x), false, false); x = __uint_as_float(a[0]) + __uint_as_float(a[1]);
    auto b = __builtin_amdgcn_permlane32_swap(__float_as_uint(x), __float_as_uint(x), false, false); return __uint_as_float(b[0]) + __uint_as_float(b[1]);
}

struct Frame {
    LAS unsigned char* lds;
    volatile LAS unsigned* MISC;
    unsigned char* ws;
    int tid, lane, wave, G;
    const float *xp, *xs, *g1, *w_in, *upf, *bf_, *upb, *bb, *gng, *w_out, *g2, *w_gate, *w_up, *w_down, *gfin;
    float* out;
};
__device__ __forceinline__ float wave_sum(float v) {
#pragma unroll
    for (int o = 1; o < 64; o <<= 1) v += __shfl_xor(v, o);
    return v;
}

template <class RowMap>
__device__ __forceinline__ void p0_transpose_item(const float* W, int K, int N, int nblk, bf16* WT, const float* kscale, LAS float* scr, int item, int lane, RowMap rowmap) {
    const int kb = item / nblk, nb = item % nblk, k0 = 64 * kb, n0 = 32 * nb;
    float wv[32];
#pragma unroll
    for (int i = 0; i < 32; ++i) wv[i] = W[(size_t)(k0 + 2 * i + (lane >> 5)) * N + n0 + (lane & 31)];
#pragma unroll
    for (int i = 0; i < 32; ++i) { const int kk = 2 * i + (lane >> 5); float v = wv[i]; if (kscale) v *= kscale[k0 + kk]; scr[kk * 33 + (lane & 31)] = v; }
    LDS_WAIT(); asm volatile("" ::: "memory");
    const int c = lane & 7;
#pragma unroll
    for (int j = 0; j < 4; ++j) { const int n = (lane >> 3) + 8 * j; const LAS float* s = scr + (8 * c) * 33 + n;
        v4u o; o.x = pk2(s[0 * 33], s[1 * 33]); o.y = pk2(s[2 * 33], s[3 * 33]); o.z = pk2(s[4 * 33], s[5 * 33]); o.w = pk2(s[6 * 33], s[7 * 33]);
        *(GAS v4u*)(WT + (size_t)rowmap(n0 + n) * K + k0 + 8 * c) = o; }
    LDS_WAIT(); asm volatile("" ::: "memory");
}
struct RowIn { __device__ __forceinline__ int operator()(int n) const {
    if (n >= 1024) return n;
    const int d = n & 63, nn = d >> 5, dd = d & 31;
    return (n & ~63) + 32 * (dd >> 4) + 8 * ((dd >> 2) & 3) + 4 * nn + (dd & 3); } };
struct RowId { __device__ __forceinline__ int operator()(int n) const { return n; } };
struct RowGU { int off; __device__ __forceinline__ int operator()(int n) const { return 256 * (n >> 7) + off + (n & 127); } };

__device__ __forceinline__ void p0_prologue(Frame& F) {
    LAS float* scr = (LAS float*)(F.lds + 69632 + F.wave * 8448);
    const int gw = blockIdx.x * NWAVES + F.wave, NGW = F.G * NWAVES;
    { const int t = F.tid, c4 = 4 * (t & 7);
#pragma unroll 4
      for (int i = 0; i < 16; ++i) { const int k = (t >> 3) + 64 * i; const f32x4 w = *(const GAS f32x4*)(F.w_in + (size_t)k * NIN + 3072 + c4);
#pragma unroll
          for (int e = 0; e < 4; ++e) { const int col = c4 + e; *(LAS unsigned short*)(F.lds + (((k >> 5) * 2 + (col >> 4)) * 64 + ((k >> 3) & 3) * 16 + (col & 15)) * 16 + (k & 7) * 2) = f2bf16(w[e] * F.g1[k]); } }
    }
    __syncthreads();
    bf16* Win = (bf16*)(F.ws + WS_WIN); bf16* Wout = (bf16*)(F.ws + WS_WOUT); bf16* Wgu = (bf16*)(F.ws + WS_WGU); bf16* Wdn = (bf16*)(F.ws + WS_WDN);
    constexpr int I_IN = 16 * 96, I_OUT = 16 * 32, I_G = 16 * (DFF / 32), I_D = (DFF / 64) * 32;
    constexpr int NITEMS = I_IN + I_OUT + 2 * I_G + I_D;
    for (int it = gw; it < NITEMS; it += NGW) {
        int r = it;
        if (r < I_IN) { p0_transpose_item(F.w_in, DM, NIN, 96, Win, F.g1, scr, r, F.lane, RowIn{}); continue; } r -= I_IN;
        if (r < I_OUT) { p0_transpose_item(F.w_out, DM, DM, 32, Wout, nullptr, scr, r, F.lane, RowId{}); continue; } r -= I_OUT;
        if (r < I_G) { p0_transpose_item(F.w_gate, DM, DFF, DFF / 32, Wgu, F.g2, scr, r, F.lane, RowGU{0}); continue; } r -= I_G;
        if (r < I_G) { p0_transpose_item(F.w_up, DM, DFF, DFF / 32, Wgu, F.g2, scr, r, F.lane, RowGU{128}); continue; } r -= I_G;
        p0_transpose_item(F.w_down, DFF, DM, 32, Wdn, nullptr, scr, r, F.lane, RowId{});
    }
    { const int gt = blockIdx.x * 512 + F.tid, NT = F.G * 512; v4u z = {0u, 0u, 0u, 0u};
      for (int i = gt; i < MT / 4; i += NT) { *(GAS v4u*)((float*)(F.ws + WS_SS1) + 4 * i) = z; *(GAS v4u*)((float*)(F.ws + WS_SS2) + 4 * i) = z; } }
    { const int gt = blockIdx.x * 512 + F.tid, NT = F.G * 512; float* rc = (float*)(F.ws + WS_ROPE); float* rs = rc + 8192 * 32;
      for (int i = gt; i < 8192 * 32; i += NT) { const int s = i >> 5, f = i & 31;
          const float inv = (float)pow(10000.0, -(double)f / 32.0); const float ang = (float)s * inv;
          rc[i] = (float)cos((double)ang); rs[i] = (float)sin((double)ang); } }
    { bf16* HN = (bf16*)(F.ws + WS_HN); float* R0 = (float*)(F.ws + WS_R0); float* RFB = (float*)(F.ws + WS_RFB);
      const int lane = F.lane, lq = lane & 15, g = lane >> 4;
      const LAS unsigned char* wrf = F.lds;
      const int per = (MT / 16 + F.G - 1) / F.G, gend = ((int)blockIdx.x + 1) * per < MT / 16 ? ((int)blockIdx.x + 1) * per : MT / 16;
      for (int grp = blockIdx.x * per + F.wave; grp < gend; grp += NWAVES) {
          const int row = grp * 16 + lq;
          const float* xrow = (row < MP ? F.xp + (size_t)row * DM : F.xs + (size_t)(row - MP) * DM) + 8 * g;
          bf16* hrow = HN + (size_t)row * DM + 8 * g;
          f32x4 acc0 = {0.f, 0.f, 0.f, 0.f}, acc1 = {0.f, 0.f, 0.f, 0.f}, sq = {0.f, 0.f, 0.f, 0.f};
#pragma unroll 1
          for (int s0 = 0; s0 < 32; s0 += 8) {
              f32x4 xa[8], xb[8];
#pragma unroll
              for (int s = 0; s < 8; ++s) { xa[s] = *(const GAS f32x4*)(xrow + 32 * (s0 + s)); xb[s] = *(const GAS f32x4*)(xrow + 32 * (s0 + s) + 4); }
#pragma unroll
              for (int s = 0; s < 8; ++s) {
                  sq = sq + xa[s] * xa[s] + xb[s] * xb[s];
                  const bf16x8 af = pack8(xa[s], xb[s]);
                  *(bf16x8*)(hrow + 32 * (s0 + s)) = af;
                  acc0 = MFMA16(af, *(const LAS bf16x8*)(wrf + (((s0 + s) * 2 + 0) * 64 + lane) * 16), acc0);
                  acc1 = MFMA16(af, *(const LAS bf16x8*)(wrf + (((s0 + s) * 2 + 1) * 64 + lane) * 16), acc1);
              }
          }
          const float ss = red4_sum((sq[0] + sq[1]) + (sq[2] + sq[3]));
          const float r = 1.0f / sqrtf(ss * (1.0f / DM) + EPS);
          if (g == 0) R0[row] = r;
#pragma unroll
          for (int e = 0; e < 4; ++e) { const float re = __shfl(r, 4 * g + e);
              RFB[(size_t)(grp * 16 + 4 * g + e) * 32 + lq] = acc0[e] * re; RFB[(size_t)(grp * 16 + 4 * g + e) * 32 + 16 + lq] = acc1[e] * re; }
      } }
}

__device__ __forceinline__ void p8_final(Frame& F) {
    const int gw = blockIdx.x * NWAVES + F.wave, NGW = F.G * NWAVES;
    const float* ss = (const float*)(F.ws + WS_SS2);
    f32x4 gv[2][2];
#pragma unroll
    for (int hh = 0; hh < 2; ++hh)
#pragma unroll
        for (int j = 0; j < 2; ++j) gv[hh][j] = *(const GAS f32x4*)(F.gfin + hh * 512 + 8 * F.lane + 4 * j);
    const bf16* X2 = (const bf16*)(F.ws + WS_MIX);
    for (int m0 = gw; m0 < MT; m0 += 8 * NGW) {
        int mr[8]; v4u w[8][2]; float r[8];
#pragma unroll
        for (int k = 0; k < 8; ++k) { mr[k] = (m0 + k * NGW < MT) ? m0 + k * NGW : m0;
            const GAS v4u* xr = (const GAS v4u*)(X2 + (size_t)mr[k] * DM) + F.lane;
            w[k][0] = xr[0]; w[k][1] = xr[64];
            r[k] = __hip_atomic_load(ss + mr[k], __ATOMIC_RELAXED, __HIP_MEMORY_SCOPE_AGENT); }
#pragma unroll
        for (int k = 0; k < 8; ++k) { const float rr = 1.0f / sqrtf(r[k] * (1.0f / DM) + EPS);
#pragma unroll
            for (int hh = 0; hh < 2; ++hh) { const v4u q = w[k][hh]; GAS f32x4* o = (GAS f32x4*)(F.out + (size_t)mr[k] * DM + hh * 512 + 8 * F.lane);
                const f32x4 a = {__uint_as_float(q.x << 16), __uint_as_float(q.x & 0xffff0000u), __uint_as_float(q.y << 16), __uint_as_float(q.y & 0xffff0000u)};
                const f32x4 b = {__uint_as_float(q.z << 16), __uint_as_float(q.z & 0xffff0000u), __uint_as_float(q.w << 16), __uint_as_float(q.w & 0xffff0000u)};
                o[0] = a * rr * gv[hh][0]; o[1] = b * rr * gv[hh][1]; } }
    }
}
struct AttnGeom { int seq_base, log2d, r, m0, tlo, thi; };
__device__ __forceinline__ void attn_geom(AttnGeom& G, int seq_base, int S, int c, int pi, int sb) {
    const int log2d = pi == 0 ? 4 : (pi == 1 ? 2 : 0), L = S >> log2d, Mres = 512 >> log2d, lg = 4 - log2d;
    G.seq_base = seq_base; G.log2d = log2d; G.r = sb >> lg; G.m0 = Mres * c + 32 * (sb & ((1 << lg) - 1));
    G.tlo = G.m0 >= 64 ? 0 : (G.m0 >= 32 ? 1 : 2);
    const int rem = L - G.m0; G.thi = rem >= 96 ? 4 : (rem >= 64 ? 3 : 2);
}
__device__ __forceinline__ int attn_row(const AttnGeom& G, int m) { return G.seq_base + (m << G.log2d) + G.r; }
__device__ __forceinline__ void attn_dma_k(const AttnGeom& G, int t, const bf16* KA, int h, int lane, LAS unsigned char* slot) {
    const int mk0 = G.m0 - 64 + 32 * t;
#pragma unroll
    for (int i = 0; i < 4; ++i) { const int row = 8 * i + (lane >> 3), p = lane & 7;
        __builtin_amdgcn_global_load_lds((const unsigned*)((const char*)KA + (unsigned)(attn_row(G, mk0 + row) * 1024 + h * 128 + 16 * (p ^ ((row >> 1) & 7)))), (LAS unsigned*)(slot + i * 1024), 16, 0, 0); }
}
__device__ __forceinline__ void attn_load_v(u32x4 (&vv)[4], const AttnGeom& G, int t, const bf16* VA, int h, int lane) {
    const int mk0 = G.m0 - 64 + 32 * t;
#pragma unroll
    for (int i = 0; i < 4; ++i) vv[i] = *(const u32x4*)((const char*)VA + (unsigned)(attn_row(G, mk0 + 8 * i + (lane >> 3)) * 1024 + h * 128 + 16 * (lane & 7)));
}

struct AttnLdsOff { int k0, vb, vx, vw0; };
template <int NQB, int PM> __device__ __forceinline__ void attn_pattern(Frame& F, const AttnGeom& G0, const AttnGeom& G1, unsigned tl0, int n0, unsigned tl1, int n1,
                                                                         int pi, int tok0, int h, LAS unsigned char* ring, LAS unsigned char* sto, LAS float* stm, LAS float* stl) {
    constexpr int NSEG = 4 / NQB;
    const int lane = F.lane, lq = lane & 15, g = lane >> 4, tq = (lane & 15) >> 2, tp = lane & 3;
    AttnLdsOff LO;
    LO.k0 = lq * 128 + ((g ^ ((lq >> 1) & 7)) << 4);
    { const int r = 4 * g + tq; LO.vx = (r >> 1) & 3; LO.vb = r * 128 + ((tp >> 1) << 4) + 8 * (tp & 1); }
    { const int row = lane >> 3, p = lane & 7; LO.vw0 = row * 128 + ((p ^ (2 * ((row >> 1) & 3))) << 4); }
    const bf16* MIX = (const bf16*)(F.ws + WS_MIX); bf16* MIXW = (bf16*)(F.ws + WS_MIX);
    const bf16* KA = (const bf16*)(F.ws + WS_KA); const bf16* VA = (const bf16*)(F.ws + WS_VA);
    const int ntot = n0 + (NSEG == 2 ? n1 : 0);
#define ATT_TILE(kk) (((kk) < n0 ? tl0 >> (4 * (kk)) : tl1 >> (4 * ((kk) - n0))) & 15u)
#define ATT_GEOM(kk) ((kk) < n0 ? G0 : G1)
    attn_dma_k(G0, (int)ATT_TILE(0), KA, h, lane, ring);
    attn_dma_k(ATT_GEOM(1), (int)ATT_TILE(1), KA, h, lane, ring + 4096);
    u32x4 vn[4]; attn_load_v(vn, G0, (int)ATT_TILE(0), VA, h, lane);
    int k = 0;
#pragma unroll 1
    for (int i = 0; i < NSEG; ++i) {
        const AttnGeom G = i == 0 ? G0 : G1; const int nseg_tiles = i == 0 ? n0 : n1;
        int qrow[NQB];
#pragma unroll
        for (int qb = 0; qb < NQB; ++qb) qrow[qb] = attn_row(G, G.m0 + 16 * qb + lq);
        bf16x8 bq[NQB][2];
#pragma unroll
        for (int qb = 0; qb < NQB; ++qb)
#pragma unroll
            for (int st = 0; st < 2; ++st) bq[qb][st] = *(const bf16x8*)((MIX + h * 64) + ((qrow[qb] * 1024 + 8 * g) + 32 * st));
        constexpr bool ACCM = NQB == 2;
        f32x4 O[4][NQB], negm[ACCM ? NQB : 1]; float mneg[NQB], lrun[NQB];
        bool fresh = (pi == 0 || PM == 1);
        if (fresh) {
#pragma unroll
            for (int qb = 0; qb < NQB; ++qb) { mneg[qb] = 0.f; lrun[qb] = 0.f;
#pragma unroll
                for (int db = 0; db < 4; ++db) O[db][qb] = (f32x4){0.f, 0.f, 0.f, 0.f}; }
        } else {
#pragma unroll
            for (int qb = 0; qb < NQB; ++qb) { const int ti = qrow[qb] - tok0;
#pragma unroll
                for (int db = 0; db < 4; ++db) { const u32x2 w = *(LAS u32x2*)(sto + ti * 136 + 32 * db + 8 * g);
                    O[db][qb] = (f32x4){__uint_as_float(w.x << 16), __uint_as_float(w.x & 0xffff0000u), __uint_as_float(w.y << 16), __uint_as_float(w.y & 0xffff0000u)}; }
                mneg[qb] = -stm[ti]; const float lt = stl[ti]; lrun[qb] = g == 0 ? lt : 0.f; }
        }
        if constexpr (ACCM) {
#pragma unroll
            for (int qb = 0; qb < NQB; ++qb) negm[qb] = (f32x4){mneg[qb], mneg[qb], mneg[qb], mneg[qb]}; }
#pragma unroll 1
        for (int j = 0; j < nseg_tiles; ++j, ++k) {
            const int t = (int)ATT_TILE(k);
            LAS unsigned char* slot = ring + (k & 1) * 4096;
            if (k + 1 < ntot) asm volatile("s_waitcnt vmcnt(8)" ::: "memory"); else asm volatile("s_waitcnt vmcnt(4)" ::: "memory");
            bf16x8 ak[2][2];
#pragma unroll
            for (int kb = 0; kb < 2; ++kb)
#pragma unroll
                for (int st = 0; st < 2; ++st) ak[kb][st] = *(LAS bf16x8*)(slot + (LO.k0 ^ (64 * st)) + kb * 2048);
            bf16x8 pb[NQB];
            const bool edge = NQB == 2 ? (t == 0 || t == 4) : (t != 2 && t != 3);
            const int lo = -32 * t, hi = 128 - 32 * t;
#pragma unroll
            for (int q0 = 0; q0 < NQB; q0 += 2) {
                f32x4 s[2][2];
#pragma unroll
                for (int kb = 0; kb < 2; ++kb)
#pragma unroll
                    for (int qq = 0; qq < 2; ++qq) { s[kb][qq] = MFMA16(ak[kb][0], bq[q0 + qq][0], ACCM ? negm[ACCM ? q0 + qq : 0] : ((f32x4){0.f, 0.f, 0.f, 0.f})); s[kb][qq] = MFMA16(ak[kb][1], bq[q0 + qq][1], s[kb][qq]); if constexpr (!ACCM) s[kb][qq] = s[kb][qq] + mneg[q0 + qq]; }
                if (edge) {
#pragma unroll
                    for (int kb = 0; kb < 2; ++kb)
#pragma unroll
                        for (int qq = 0; qq < 2; ++qq)
#pragma unroll
                            for (int e = 0; e < 4; ++e) { const int dlt = (16 * kb + 4 * g + e) - (16 * (q0 + qq) + lq); if (dlt < lo || dlt > hi) s[kb][qq][e] = -1e30f; }
                }
                float mx[2];
#pragma unroll
                for (int qq = 0; qq < 2; ++qq) mx[qq] = red4_max(fmaxf(fmaxf(fmaxf(s[0][qq][0], s[0][qq][1]), fmaxf(s[0][qq][2], s[0][qq][3])), fmaxf(fmaxf(s[1][qq][0], s[1][qq][1]), fmaxf(s[1][qq][2], s[1][qq][3]))));
                if (fresh || __any(mx[0] > 0.f || mx[1] > 0.f)) {
#pragma unroll
                    for (int qq = 0; qq < 2; ++qq) { const int qb = q0 + qq;
                        const float d = fresh ? mx[qq] : fmaxf(mx[qq], 0.f), alpha = fresh ? 1.0f : __builtin_amdgcn_exp2f(-d);
                        mneg[qb] -= d; if constexpr (ACCM) negm[qb] = negm[qb] - d;
#pragma unroll
                        for (int kb = 0; kb < 2; ++kb) s[kb][qq] = s[kb][qq] - d;
                        lrun[qb] *= alpha;
#pragma unroll
                        for (int db = 0; db < 4; ++db) O[db][qb] = O[db][qb] * alpha;
                    }
                }
#pragma unroll
                for (int qq = 0; qq < 2; ++qq) { const int qb = q0 + qq;
                    f32x4 p0, p1;
#pragma unroll
                    for (int e = 0; e < 4; ++e) { p0[e] = __builtin_amdgcn_exp2f(s[0][qq][e]); p1[e] = __builtin_amdgcn_exp2f(s[1][qq][e]); }
                    lrun[qb] += ((p0[0] + p0[1]) + (p0[2] + p0[3])) + ((p1[0] + p1[1]) + (p1[2] + p1[3]));
                    pb[qb] = pack8(p0, p1);
                }
                if (NQB == 4 && q0 == 0) asm volatile("" : "+v"(ak[0][0]), "+v"(ak[0][1]), "+v"(ak[1][0]), "+v"(ak[1][1]) : "v"(pb[0]), "v"(pb[1]));
            }
            fresh = false;
#pragma unroll
            for (int i4 = 0; i4 < 4; ++i4) *(LAS u32x4*)(slot + LO.vw0 + i4 * 1024) = vn[i4];
#pragma unroll
            for (int db = 0; db < 4; ++db) {
                const bf16x8 av = cat8(ldtr(slot + LO.vb + ((db ^ LO.vx) << 5)), ldtr(slot + LO.vb + ((db ^ LO.vx) << 5) + 2048));
#pragma unroll
                for (int qb = 0; qb < NQB; ++qb) O[db][qb] = MFMA16(av, pb[qb], O[db][qb]);
            }
            asm volatile("s_waitcnt lgkmcnt(0)" ::: "memory");
            if (k + 2 < ntot) attn_dma_k(ATT_GEOM(k + 2), (int)ATT_TILE(k + 2), KA, h, lane, slot);
            { const int k1 = k + 1 < ntot ? k + 1 : k; attn_load_v(vn, ATT_GEOM(k1), (int)ATT_TILE(k1), VA, h, lane); }
        }
#pragma unroll
        for (int qb = 0; qb < NQB; ++qb) {
            float lt = red4_sum(lrun[qb]);
            if (PM == 1 && pi < 2) { asm volatile("" :: "v"(O[0][qb]), "v"(O[1][qb]), "v"(O[2][qb]), "v"(O[3][qb]), "v"(lt)); }
            else if (pi < 2) { const int ti = attn_row(G, G.m0 + 16 * qb + lq) - tok0;
#pragma unroll
                for (int db = 0; db < 4; ++db) { u32x2 w; w.x = cvtpk(O[db][qb][0], O[db][qb][1]); w.y = cvtpk(O[db][qb][2], O[db][qb][3]); *(LAS u32x2*)(sto + ti * 136 + 32 * db + 8 * g) = w; }
                if (g == 0) { stm[ti] = -mneg[qb]; stl[ti] = lt; }
            } else { const float inv = 1.0f / lt;
#pragma unroll
                for (int db = 0; db < 4; ++db) { const f32x4 o = O[db][qb] * inv; u32x2 w; w.x = cvtpk(o[0], o[1]); w.y = cvtpk(o[2], o[3]);
                    *(u32x2*)((MIXW + h * 64) + ((attn_row(G, G.m0 + 16 * qb + lq) * 1024 + 4 * g) + 16 * db)) = w; }
            }
        }
    }
#undef ATT_TILE
#undef ATT_GEOM
}

template <int PM> __device__ __forceinline__ void attn_phase(Frame& F, unsigned* queue) {
    const int wave = F.wave;
    LAS unsigned char* ring = F.lds + wave * 8192;
    LAS unsigned char* sto = F.lds + 65536;
    LAS float* stm = (LAS float*)(F.lds + 65536 + 512 * 136); LAS float* stl = stm + 512;
    for (int item = blockIdx.x;; item += F.G) {
        if (queue) {
            if (F.tid == 0) F.MISC[20] = __hip_atomic_fetch_add(queue, 1u, __ATOMIC_RELAXED, __HIP_MEMORY_SCOPE_AGENT);
            __syncthreads();
            item = (int)F.MISC[20];
        }
        if (item >= (MT / 512) * 8) break;
        const int cc = item >> 3, h = item & 7, tok0 = cc * 512;
        const int S = tok0 < MP ? 4096 : 8192, seq_base = tok0 & ~(S - 1), c = (tok0 - seq_base) >> 9;
        {
            AttnGeom G0, G1; attn_geom(G0, seq_base, S, c, 0, 2 * wave); attn_geom(G1, seq_base, S, c, 0, 2 * wave + 1);
            unsigned tl0 = 0, tl1 = 0; int n0 = 0, n1 = 0;
            for (int t = G0.tlo; t <= G0.thi; ++t) tl0 |= (unsigned)t << (4 * n0++);
            for (int t = G1.tlo; t <= G1.thi; ++t) tl1 |= (unsigned)t << (4 * n1++);
            attn_pattern<2, PM>(F, G0, G1, tl0, n0, tl1, n1, 0, tok0, h, ring, sto, stm, stl);
            __syncthreads();
        }
#pragma unroll 1
        for (int pi = 1; pi < 3; ++pi) {
            AttnGeom G0; attn_geom(G0, seq_base, S, c, pi, 2 * wave);
            const int L = S >> G0.log2d, m0 = G0.m0;
            unsigned tl0 = 2u | (3u << 4); int n0 = 2;
            if (m0 >= 32) tl0 |= 1u << (4 * n0++);
            if (m0 + 96 <= L) tl0 |= 4u << (4 * n0++);
            if (m0 >= 64) tl0 |= 0u << (4 * n0++);
            if (m0 + 128 <= L) tl0 |= 5u << (4 * n0++);
            attn_pattern<4, PM>(F, G0, G0, tl0, n0, 0u, 0, pi, tok0, h, ring, sto, stm, stl);
            __syncthreads();
        }
    }
}
__device__ __forceinline__ void gla_load_v(Frame& F, int row0) {
    const bf16* VG = (const bf16*)(F.ws + WS_VG);
#pragma unroll
    for (int i = 0; i < 8; ++i) { const int s = F.wave + 8 * i;
        const u32x4 v = *(const u32x4*)(VG + (size_t)(row0 + s) * 512 + 8 * F.lane);
        *(LAS u32x4*)(F.lds + G_VT + (F.lane >> 4) * G_VT_HEAD + s * 288 + (F.lane & 15) * 16) = v; }
}

__device__ __forceinline__ void gla_g1(Frame& F, int first, int GS) {
    const int lane = F.lane, wave = F.wave, lq = lane & 15, g = lane >> 4, tq = (lane & 15) >> 2, tp = lane & 3;
    const int h = wave >> 1, dir = wave & 1;
    const bf16* __restrict__ MIX = (const bf16*)(F.ws + WS_MIX);
    bf16* __restrict__ QE = (bf16*)(F.ws + WS_QE) + (size_t)(2 * dir) * QE_STRIDE; bf16* __restrict__ KE = (bf16*)(F.ws + WS_QE) + (size_t)(2 * dir + 1) * QE_STRIDE;
    bf16* KVT = (bf16*)(F.ws + WS_KVT); float* DEC = (float*)(F.ws + WS_DECAY);
    const float* RFB = (const float*)(F.ws + WS_RFB);
    const float* up = dir ? F.upb : F.upf; const float* bias = dir ? F.bb : F.bf_;
    f32x4 up4[4];
#pragma unroll
    for (int r = 0; r < 16; ++r) up4[r >> 2][r & 3] = up[r * 256 + h * 64 + lane] * 1.4426950408889634f;
    const float bs = bias[h * 64 + lane] * 1.4426950408889634f;
    LAS float* rfl = (LAS float*)(F.lds + G_RF) + dir * 1024;
    LAS unsigned char* kel = F.lds + G_KE + wave * 9216;
    LAS float* cl = (LAS float*)(F.lds + G_CL) + wave * 64;
    LAS unsigned char* vt = F.lds + G_VT + h * G_VT_HEAD;
    const bf16* VG = (const bf16*)(F.ws + WS_VG);
    const int rs = F.tid >> 3, rch = F.tid & 7;
    int ci = first;
    if (ci >= NCHUNK) return;
    f32x4 rfreg = *(const f32x4*)(RFB + (size_t)(ci * 64 + rs) * 32 + 4 * rch);
    unsigned short qn[16], kn[16];
#pragma unroll
    for (int j = 0; j < 16; ++j) { const size_t row = (size_t)(ci * 64 + (dir ? 63 - j : j)); qn[j] = MIX[row * 1024 + 512 + h * 64 + lane]; kn[j] = MIX[row * 1024 + 768 + h * 64 + lane]; }
    for (;;) {
        const int row0 = ci * 64, cn = ci + GS; const bool has_next = cn < NCHUNK;
        *(LAS f32x4*)((LAS float*)(F.lds + G_RF) + (rch >> 2) * 1024 + rs * 16 + 4 * (rch & 3)) = rfreg;
        __syncthreads();
        u32x4 vr[8];
#pragma unroll
        for (int i = 0; i < 8; ++i) vr[i] = *(const u32x4*)(VG + (size_t)(row0 + wave + 8 * i) * 512 + 8 * lane);
        float cum = 0.f;
#pragma unroll 1
        for (int b = 0; b < 4; ++b) {
            unsigned short qc[16], kc[16];
#pragma unroll
            for (int j = 0; j < 16; ++j) { qc[j] = qn[j]; kc[j] = kn[j]; }
            if (b < 3) {
#pragma unroll
                for (int j = 0; j < 16; ++j) { const int ss = 16 * (b + 1) + j; const size_t row = (size_t)(row0 + (dir ? 63 - ss : ss)); qn[j] = MIX[row * 1024 + 512 + h * 64 + lane]; kn[j] = MIX[row * 1024 + 768 + h * 64 + lane]; }
            }
#pragma unroll
            for (int jb = 0; jb < 4; ++jb) {
                f32x4 rr[4][4];
#pragma unroll
                for (int j4 = 0; j4 < 4; ++j4) { const int ss = 16 * b + 4 * jb + j4, s = dir ? 63 - ss : ss;
#pragma unroll
                    for (int q = 0; q < 4; ++q) rr[j4][q] = *(LAS f32x4*)(rfl + s * 16 + 4 * q); }
                float la[4];
#pragma unroll
                for (int j4 = 0; j4 < 4; ++j4) {
                    const f32x4 z4 = rr[j4][0] * up4[0] + rr[j4][1] * up4[1] + rr[j4][2] * up4[2] + rr[j4][3] * up4[3];
                    const float z = bs + ((z4[0] + z4[1]) + (z4[2] + z4[3]));
                    la[j4] = fminf(z, 0.f) - __builtin_amdgcn_logf(1.0f + __builtin_amdgcn_exp2f(-fabsf(z)));
                }
#pragma unroll
                for (int j4 = 0; j4 < 4; ++j4) { const int j = 4 * jb + j4, ss = 16 * b + j, s = dir ? 63 - ss : ss;
                    cum = __builtin_fmaf(la[j4], 1.0f / 16.0f, cum);
                    const size_t row = (size_t)(row0 + s);
                    const float e = __builtin_amdgcn_exp2f(cum), qe = bf2f(qc[j]) * e, ke = bf2f(kc[j]) * __builtin_amdgcn_rcpf(e);
                    const unsigned short keb = f2bf16(ke);
                    QE[row * 256 + h * 64 + lane] = f2bf16(qe); KE[row * 256 + h * 64 + lane] = keb;
                    *(LAS unsigned short*)(kel + lane * 144 + s * 2) = keb;
                }
            }
        }
        cl[lane] = cum;
        const int itemi = (ci * 4 + h) * 2 + dir;
        DEC[(size_t)itemi * 64 + lane] = __builtin_amdgcn_exp2f(cum);
#pragma unroll
        for (int i = 0; i < 8; ++i) *(LAS u32x4*)(F.lds + G_VT + (lane >> 4) * G_VT_HEAD + (wave + 8 * i) * 288 + (lane & 15) * 16) = vr[i];
        __syncthreads();
        { const int cl_ = has_next ? cn : ci;
          rfreg = *(const f32x4*)(RFB + (size_t)(cl_ * 64 + rs) * 32 + 4 * rch);
#pragma unroll
          for (int j = 0; j < 16; ++j) { const size_t row = (size_t)(cl_ * 64 + (dir ? 63 - j : j)); qn[j] = MIX[row * 1024 + 512 + h * 64 + lane]; kn[j] = MIX[row * 1024 + 768 + h * 64 + lane]; } }
        bf16x8 af[4][2];
#pragma unroll
        for (int cb = 0; cb < 4; ++cb)
#pragma unroll
            for (int ks = 0; ks < 2; ++ks) af[cb][ks] = *(LAS bf16x8*)(kel + (16 * cb + lq) * 144 + (32 * ks + 8 * g) * 2);
        f32x4 scl[4];
#pragma unroll
        for (int cb = 0; cb < 4; ++cb) { const f32x4 c4 = *(LAS f32x4*)(cl + 16 * cb + 4 * g); scl[cb] = (f32x4){__builtin_amdgcn_exp2f(c4[0]), __builtin_amdgcn_exp2f(c4[1]), __builtin_amdgcn_exp2f(c4[2]), __builtin_amdgcn_exp2f(c4[3])}; }
#pragma unroll 1
        for (int half = 0; half < 2; ++half) {
            f32x4 acc[4][4];
#pragma unroll
            for (int cb = 0; cb < 4; ++cb)
#pragma unroll
                for (int d = 0; d < 4; ++d) acc[cb][d] = (f32x4){0.f, 0.f, 0.f, 0.f};
#pragma unroll
            for (int d = 0; d < 4; ++d) { const int db = half * 4 + d;
#pragma unroll
                for (int ks = 0; ks < 2; ++ks) {
                    const bf16x8 bv = cat8(ldtr(vt + (32 * ks + 8 * g + tq) * 288 + (16 * db + 4 * tp) * 2), ldtr(vt + (32 * ks + 8 * g + 4 + tq) * 288 + (16 * db + 4 * tp) * 2));
#pragma unroll
                    for (int cb = 0; cb < 4; ++cb) acc[cb][d] = MFMA16(af[cb][ks], bv, acc[cb][d]);
                } }
#pragma unroll
            for (int d = 0; d < 4; ++d) { const int dv = 16 * (half * 4 + d) + lq;
#pragma unroll
                for (int cb = 0; cb < 4; ++cb) { const f32x4 v = acc[cb][d] * scl[cb]; u32x2 w; w.x = cvtpk(v[0], v[1]); w.y = cvtpk(v[2], v[3]);
                    *(u32x2*)(KVT + (size_t)itemi * 8192 + (((half * 4 + d) * 2 + (cb >> 1)) * 64 + (2 * (cb & 1) + (g >> 1)) * 16 + lq) * 8 + 4 * (g & 1)) = w; } }
        }
        if (!has_next) break;
        ci = cn;
    }
    __syncthreads();
}

__device__ __forceinline__ void gla_g2(Frame& F, int first, int GS) {
    const bf16* KVT = (const bf16*)(F.ws + WS_KVT); const float* __restrict__ DEC = (const float*)(F.ws + WS_DECAY); bf16* ST = (bf16*)(F.ws + WS_KVT);
    for (int it = first; it < 768; it += GS) {
        int nch, cbase, rem;
        if (it < 256) { nch = 64; cbase = (it >> 6) * 64; rem = it & 63; } else { const int j = it - 256; nch = 128; cbase = 256 + (j >> 6) * 128; rem = j & 63; }
        const int h = rem >> 4, dir = (rem >> 3) & 1, part = rem & 7;
        const int e = part * 512 + F.tid, o2 = 2 * e, dk = 32 * ((o2 >> 9) & 1) + 8 * ((o2 >> 7) & 3) + (o2 & 7);
        float s0 = 0.f, s1 = 0.f;
        const size_t eoff = (size_t)o2;
        unsigned kvn[16]; f32x2v dcn[16];
#pragma unroll
        for (int j = 0; j < 16; ++j) { const int ci = cbase + (dir ? nch - 1 - j : j); const size_t itemi = (size_t)(ci * 4 + h) * 2 + dir;
            kvn[j] = *(const unsigned*)(KVT + itemi * 8192 + eoff); dcn[j] = *(const f32x2v*)(DEC + itemi * 64 + dk); }
#pragma unroll 1
        for (int n0 = 0; n0 < nch; n0 += 16) {
            unsigned kvc[16]; f32x2v dcc[16];
#pragma unroll
            for (int j = 0; j < 16; ++j) { kvc[j] = kvn[j]; dcc[j] = dcn[j]; }
            if (n0 + 16 < nch) {
#pragma unroll
                for (int j = 0; j < 16; ++j) { const int n = n0 + 16 + j; const int ci = cbase + (dir ? nch - 1 - n : n); const size_t itemi = (size_t)(ci * 4 + h) * 2 + dir;
                    kvn[j] = *(const unsigned*)(KVT + itemi * 8192 + eoff); dcn[j] = *(const f32x2v*)(DEC + itemi * 64 + dk); }
            }
#pragma unroll
            for (int j = 0; j < 16; ++j) { const int n = n0 + j; const int ci = cbase + (dir ? nch - 1 - n : n); const size_t itemi = (size_t)(ci * 4 + h) * 2 + dir;
                *(unsigned*)(ST + itemi * 8192 + eoff) = cvtpk(s0, s1);
                s0 = s0 * dcc[j].x + bf2f((unsigned short)(kvc[j] & 0xffffu)); s1 = s1 * dcc[j].y + bf2f((unsigned short)(kvc[j] >> 16)); }
        }
    }
}

struct G3A { bf16x8 bq[2][2]; bf16x8 ak[2][2][2]; };
struct G3S { bf16x8 as[8][2]; };
__device__ __forceinline__ void g3_load_a(G3A& R, const bf16* QEb, int ci, int h, int chalf, int dir, int lq, int g) {
    const bf16* qb = QEb + (size_t)(2 * dir) * QE_STRIDE + (size_t)(ci * 64) * 256 + h * 64;
    const bf16* kb = qb + QE_STRIDE;
    const int lo = lq * 256 + 8 * g, qo = lo + 32 * chalf * 256;
#pragma unroll
    for (int cb = 0; cb < 2; ++cb)
#pragma unroll
        for (int st = 0; st < 2; ++st) R.bq[cb][st] = *(const bf16x8*)(qb + (qo + (16 * cb * 256 + 32 * st)));
#pragma unroll
    for (int ks = 0; ks < 2; ++ks)
#pragma unroll
        for (int sb = 0; sb < 2; ++sb)
#pragma unroll
            for (int st = 0; st < 2; ++st) R.ak[ks][sb][st] = *(const bf16x8*)(kb + (lo + ((32 * ks + 16 * sb) * 256 + 32 * st)));
}
__device__ __forceinline__ void g3_load_s(G3S& R, const bf16* ST, int ci, int h, int dir, int lq, int g) {
    const bf16* sb = ST + ((size_t)(ci * 4 + h) * 2 + dir) * 8192;
    const int lo = (g * 16 + lq) * 8;
#pragma unroll
    for (int db = 0; db < 8; ++db)
#pragma unroll
        for (int st = 0; st < 2; ++st) R.as[db][st] = *(const bf16x8*)(sb + (lo + (db * 2 + st) * 512));
}
__device__ __forceinline__ void g3_intra(f32x4 (&O)[8][2], const G3A& R, LAS unsigned char* vt, int dir, int chalf, int lq, int g, int tq, int tp) {
#pragma unroll
    for (int ks = 0; ks < 2; ++ks) {
        bf16x8 pb[2];
#pragma unroll
        for (int cb = 0; cb < 2; ++cb) {
            f32x4 sa[2];
#pragma unroll
            for (int sb = 0; sb < 2; ++sb) { sa[sb] = MFMA16(R.ak[ks][sb][0], R.bq[cb][0], ((f32x4){0.f, 0.f, 0.f, 0.f})); sa[sb] = MFMA16(R.ak[ks][sb][1], R.bq[cb][1], sa[sb]);
#pragma unroll
                for (int e = 0; e < 4; ++e) { const int s = 32 * ks + 16 * sb + 4 * g + e, c = 32 * chalf + 16 * cb + lq; const bool keep = dir ? (s > c) : (s <= c); if (!keep) sa[sb][e] = 0.f; } }
            pb[cb] = pack8(sa[0], sa[1]);
        }
#pragma unroll
        for (int db = 0; db < 8; ++db) {
            const bf16x8 av = cat8(ldtr(vt + (32 * ks + 4 * g + tq) * 288 + (16 * db + 4 * tp) * 2), ldtr(vt + (32 * ks + 16 + 4 * g + tq) * 288 + (16 * db + 4 * tp) * 2));
#pragma unroll
            for (int cb = 0; cb < 2; ++cb) O[db][cb] = MFMA16(av, pb[cb], O[db][cb]);
        }
    }
}
__device__ __forceinline__ void g3_inter(f32x4 (&O)[8][2], const G3S& S, const bf16x8 (&bq)[2][2]) {
#pragma unroll
    for (int db = 0; db < 8; ++db)
#pragma unroll
        for (int st = 0; st < 2; ++st)
#pragma unroll
            for (int cb = 0; cb < 2; ++cb) O[db][cb] = MFMA16(S.as[db][st], bq[cb][st], O[db][cb]);
}
__device__ __forceinline__ void g3_keep_a(const G3A& R) {
#pragma unroll
    for (int a = 0; a < 2; ++a)
#pragma unroll
        for (int b = 0; b < 2; ++b) { asm volatile("" :: "v"(R.bq[a][b]));
#pragma unroll
            for (int c = 0; c < 2; ++c) asm volatile("" :: "v"(R.ak[a][b][c])); }
}
__device__ __forceinline__ void g3_keep_s(const G3S& R) {
#pragma unroll
    for (int db = 0; db < 8; ++db)
#pragma unroll
        for (int st = 0; st < 2; ++st) asm volatile("" :: "v"(R.as[db][st]));
}
template <int PM> __device__ __forceinline__ void gla_g3(Frame& F, unsigned* queue) {
    const int lane = F.lane, wave = F.wave, lq = lane & 15, g = lane >> 4, tq = (lane & 15) >> 2, tp = lane & 3;
    const int h = wave >> 1, chalf = wave & 1;
    const bf16* QEb = (const bf16*)(F.ws + WS_QE); const bf16* ST = (const bf16*)(F.ws + WS_KVT); const bf16* OG = (const bf16*)(F.ws + WS_OG);
    const bf16* VG = (const bf16*)(F.ws + WS_VG);
    bf16* MIXW = (bf16*)(F.ws + WS_MIX);
    int p = 0;
    if (F.tid == 0) F.MISC[21] = __hip_atomic_fetch_add(queue, 1u, __ATOMIC_RELAXED, __HIP_MEMORY_SCOPE_AGENT);
    __syncthreads();
    int ci = (int)F.MISC[21];
    __syncthreads();
    if (ci >= NCHUNK) return;
    u32x4 vr[8];
#pragma unroll
    for (int i = 0; i < 8; ++i) vr[i] = *(const u32x4*)((VG + (size_t)(ci * 64 + wave) * 512) + (8 * lane + 8 * i * 512));
    G3A A0; g3_load_a(A0, QEb, ci, h, chalf, 0, lq, g);
#pragma unroll
    for (int i = 0; i < 8; ++i) *(LAS u32x4*)(F.lds + G_VT + (lane >> 4) * G_VT_HEAD + (wave + 8 * i) * 288 + (lane & 15) * 16) = vr[i];
    __syncthreads();
    for (;;) {
        if (F.tid == 0) F.MISC[21] = __hip_atomic_fetch_add(queue, 1u, __ATOMIC_RELAXED, __HIP_MEMORY_SCOPE_AGENT);
        __syncthreads();
        const int row0 = ci * 64, cn = (int)F.MISC[21]; const bool has_next = cn < NCHUNK;
        LAS unsigned char* vt = F.lds + G_VT + p * (4 * G_VT_HEAD) + h * G_VT_HEAD;
        const int cl_ = PM == 2 ? (int)blockIdx.x + ((ci / F.G) & 1) * F.G : ci;
        G3S S0; g3_load_s(S0, ST, cl_, h, 0, lq, g);
        f32x4 O[8][2];
#pragma unroll
        for (int db = 0; db < 8; ++db)
#pragma unroll
            for (int cb = 0; cb < 2; ++cb) O[db][cb] = (f32x4){0.f, 0.f, 0.f, 0.f};
        if (PM != 1) g3_intra(O, A0, vt, 0, chalf, lq, g, tq, tp); else g3_keep_a(A0);
        G3A A1; g3_load_a(A1, QEb, cl_, h, chalf, 1, lq, g);
        if (PM != 1) g3_inter(O, S0, A0.bq); else g3_keep_s(S0);
        G3S S1; g3_load_s(S1, ST, cl_, h, 1, lq, g);
        if (PM != 1) g3_intra(O, A1, vt, 1, chalf, lq, g, tq, tp); else g3_keep_a(A1);
        if (PM != 1) g3_inter(O, S1, A1.bq); else g3_keep_s(S1);
        __builtin_amdgcn_sched_barrier(0);
        u32x2 ogw[8];
#pragma unroll
        for (int db = 0; db < 8; ++db) ogw[db] = *(const u32x2*)((OG + (size_t)((PM == 2 ? cl_ * 64 : row0) + 32 * chalf) * 512 + h * 128) + ((lq * 512 + 4 * g) + 16 * db));
        { const int cl = PM == 2 ? (int)blockIdx.x + ((cn / F.G) & 1) * F.G : (has_next ? cn : ci);
#pragma unroll
          for (int i = 0; i < 8; ++i) vr[i] = *(const u32x4*)((VG + (size_t)(cl * 64 + wave) * 512) + (8 * lane + 8 * i * 512));
          g3_load_a(A0, QEb, cl, h, chalf, 0, lq, g); }
#pragma unroll
        for (int cb = 0; cb < 2; ++cb) {
            float q = 0.f;
#pragma unroll
            for (int db = 0; db < 8; ++db) { const f32x4 v = O[db][cb]; q += (v[0] * v[0] + v[1] * v[1]) + (v[2] * v[2] + v[3] * v[3]); }
            q += __shfl_xor(q, 16); q += __shfl_xor(q, 32);
            const float rinv = 1.0f / sqrtf(q * (1.0f / 128.0f) + EPS);
            const size_t row = (size_t)(row0 + 32 * chalf + 16 * cb + lq);
            u32x2 ogc[8];
#pragma unroll
            for (int db = 0; db < 8; ++db) ogc[db] = ogw[db];
            if (cb == 0) {
#pragma unroll
                for (int db = 0; db < 8; ++db) ogw[db] = *(const u32x2*)((OG + (size_t)((PM == 2 ? cl_ * 64 : row0) + 32 * chalf) * 512 + h * 128) + ((lq * 512 + 4 * g) + (16 * 512 + 16 * db)));
            }
#pragma unroll
            for (int db = 0; db < 8; ++db) { const int dv = 16 * db + 4 * g;
                const f32x4 gn = *(const f32x4*)((F.gng + h * 128) + (4 * g + 16 * db));
                const u32x2 w0 = ogc[db];
                const f32x4 og = {bf2f((unsigned short)(w0.x & 0xffffu)), bf2f((unsigned short)(w0.x >> 16)), bf2f((unsigned short)(w0.y & 0xffffu)), bf2f((unsigned short)(w0.y >> 16))};
                const f32x4 o = O[db][cb] * rinv * gn * og; u32x2 w; w.x = cvtpk(o[0], o[1]); w.y = cvtpk(o[2], o[3]);
                *(u32x2*)((MIXW + (size_t)(row0 + 32 * chalf) * 1024 + 512 + h * 128) + ((lq * 1024 + 4 * g) + (16 * cb * 1024 + 16 * db))) = w; }
        }
        if (!has_next) break;
        p ^= 1;
        { int l2; asm volatile("v_mbcnt_lo_u32_b32 %0, -1, 0\n\tv_mbcnt_hi_u32_b32 %0, -1, %0" : "=v"(l2));
#pragma unroll
        for (int i = 0; i < 8; ++i) *(LAS u32x4*)(F.lds + G_VT + p * (4 * G_VT_HEAD) + (l2 >> 4) * G_VT_HEAD + (wave + 8 * i) * 288 + (l2 & 15) * 16) = vr[i]; }
        __syncthreads();
        ci = cn;
    }
    __syncthreads();
}
constexpr int N_PHASES = 9;
struct Args { const float* in[15]; float* out; unsigned char* ws; int ph_lo, ph_hi; };
static_assert(sizeof(Args) == 17 * 8 + 8, "Args has no padding");

__global__ void __launch_bounds__(NWAVES * 64, 2) fwd_kernel(Args args) {
    extern __shared__ __attribute__((aligned(16))) unsigned char lds[];
    Frame F;
    F.lds = (LAS unsigned char*)lds;
    F.MISC = (volatile LAS unsigned*)(F.lds + MISC_OFF);
    F.tid = threadIdx.x; F.lane = F.tid & 63; F.wave = __builtin_amdgcn_readfirstlane(F.tid >> 6);
#define FRESH_LANE() do { int l_; asm volatile("v_mbcnt_lo_u32_b32 %0, -1, 0\n\tv_mbcnt_hi_u32_b32 %0, -1, %0" : "=v"(l_)); F.lane = l_; } while (0)
    F.G = gridDim.x; F.ws = args.ws; F.out = args.out;
    F.xp = args.in[0]; F.xs = args.in[1]; F.g1 = args.in[2]; F.w_in = args.in[3]; F.upf = args.in[4]; F.bf_ = args.in[5]; F.upb = args.in[6]; F.bb = args.in[7];
    F.gng = args.in[8]; F.w_out = args.in[9]; F.g2 = args.in[10]; F.w_gate = args.in[11]; F.w_up = args.in[12]; F.w_down = args.in[13]; F.gfin = args.in[14];
    for (int u = F.tid; u < 64; u += NWAVES * 64) F.MISC[u] = 0u;
    __syncthreads();
    const int lo = args.ph_lo, hi = args.ph_hi;
    gu32* ctl = (gu32*)(F.ws + WS_CTL);
    XcdBarrier bar; bar.bar = (unsigned*)(ctl + CW_BAR); bar.x = 0; bar.st = nullptr;
    if (hi - lo > 1) bar = xcd_barrier_post((unsigned*)(ctl + CW_BAR), F.MISC + 8);
#define IN(k) (lo <= (k) && (k) < hi)
#define SEAM(k) do { if (IN(k) && IN((k) + 1)) xcd_barrier(bar); } while (0)

    if (IN(0)) { FRESH_LANE(); p0_prologue(F); } SEAM(0);

    if (IN(1)) {
        pg8::Gemm g{(const pg8::bf16_t*)(F.ws + WS_HN), (const pg8::bf16_t*)(F.ws + WS_WIN), MT, 3072, DM}; pg8::StaticOrder S; S.init(MT, 3072, F.G, (int)blockIdx.x);
        pg8::EpiInProj E{(pg8::bf16_t*)(F.ws + WS_MIX), (pg8::bf16_t*)(F.ws + WS_KA), (pg8::bf16_t*)(F.ws + WS_VA), (pg8::bf16_t*)(F.ws + WS_VG), (pg8::bf16_t*)(F.ws + WS_OG),
                         (const float*)(F.ws + WS_R0), (const float*)(F.ws + WS_ROPE), (const float*)(F.ws + WS_ROPE) + 8192 * 32};
        pg8::gemm_phase<pg8::EpiInProj, pg8::StaticOrder, true, true>(F.lds, g, S, E);
    } SEAM(1);

    if (IN(2)) {
        unsigned* ctlw = (unsigned*)(F.ws + WS_CTL);
        if ((int)blockIdx.x < TEAM_WGS) {
            FRESH_LANE(); gla_g1(F, (int)blockIdx.x, TEAM_WGS);
            team_barrier(ctlw + CW_TEAM, (unsigned)TEAM_WGS, ctlw + CW_BAR + 128);
            FRESH_LANE(); gla_g2(F, (int)blockIdx.x, TEAM_WGS);
            team_barrier(ctlw + CW_TEAM + 32, (unsigned)TEAM_WGS, ctlw + CW_BAR + 128);
            FRESH_LANE(); gla_g3<0>(F, ctlw + CW_GQ);
            FRESH_LANE(); attn_phase<0>(F, ctlw + CW_AQ);
        } else {
            FRESH_LANE(); attn_phase<0>(F, ctlw + CW_AQ);
            team_wait(ctlw + CW_TEAM + 32, (unsigned)TEAM_WGS, ctlw + CW_BAR + 128);
            FRESH_LANE(); gla_g3<0>(F, ctlw + CW_GQ);
        }
    } SEAM(2);

    if (IN(5)) {
        pg8::Gemm g{(const pg8::bf16_t*)(F.ws + WS_MIX), (const pg8::bf16_t*)(F.ws + WS_WOUT), MT, DM, DM}; pg8::StaticOrder S; S.init(MT, DM, F.G, (int)blockIdx.x);
        pg8::EpiOutProj E{(pg8::bf16_t*)(F.ws + WS_HN), (float*)(F.ws + WS_SS1)};
        pg8::gemm_phase<pg8::EpiOutProj, pg8::StaticOrder, true, true>(F.lds, g, S, E);
    } SEAM(5);

    if (IN(6)) {
        pg8::Gemm g{(const pg8::bf16_t*)(F.ws + WS_HN), (const pg8::bf16_t*)(F.ws + WS_WGU), MT, 2 * DFF, DM}; pg8::StaticOrder S; S.init(MT, 2 * DFF, F.G, (int)blockIdx.x);
        pg8::EpiFfn1 E{(pg8::bf16_t*)(F.ws + WS_H), (const float*)(F.ws + WS_SS1)};
        pg8::gemm_phase<pg8::EpiFfn1, pg8::StaticOrder, true, true>(F.lds, g, S, E);
    } SEAM(6);

    const bool fuse_final = (F.G == 256);
    if (IN(7) && !fuse_final) {
        pg8::Gemm g{(const pg8::bf16_t*)(F.ws + WS_H), (const pg8::bf16_t*)(F.ws + WS_WDN), MT, DM, DFF}; pg8::StaticOrder S; S.init(MT, DM, F.G, (int)blockIdx.x);
        pg8::EpiFfn2 E{(const pg8::bf16_t*)(F.ws + WS_HN), (pg8::bf16_t*)(F.ws + WS_MIX), (float*)(F.ws + WS_SS2)};
        pg8::gemm_phase<pg8::EpiFfn2, pg8::StaticOrder, true, true>(F.lds, g, S, E);
    }
    if (IN(7) && fuse_final) {
        pg8::Gemm g{(const pg8::bf16_t*)(F.ws + WS_H), (const pg8::bf16_t*)(F.ws + WS_WDN), MT, DM, DFF}; pg8::StaticOrder S; S.init(MT, DM, F.G, (int)blockIdx.x);
        pg8::EpiFfn2F E{(const pg8::bf16_t*)(F.ws + WS_HN), F.out, (float*)(F.ws + WS_SS2), (unsigned*)(F.ws + WS_CTL) + CW_MEET, (unsigned*)(F.ws + WS_CTL) + CW_BAR + 128, F.gfin};
        pg8::gemm_phase<pg8::EpiFfn2F, pg8::StaticOrder, true, true>(F.lds, g, S, E);
    }
    if (!fuse_final) { SEAM(7); if (IN(8)) { p8_final(F); } }
#undef IN
#undef FRESH_LANE
#undef SEAM
}

extern "C" void kernel_launch(void* const* d_in, const int* in_sizes, int n_in, void* d_out, int out_size, void* d_ws, size_t ws_size, hipStream_t stream) {
    static int grid = 0;
    if (grid == 0) {
        if (n_in != 15 || in_sizes[0] != MP * DM || in_sizes[1] != MS * DM || out_size != MT * DM || ws_size < WS_END) {
            fprintf(stderr, "kernel_launch: unexpected shapes (n_in %d, in0 %d, in1 %d, out %d, ws %zu); nothing launched\n", n_in, n_in > 0 ? in_sizes[0] : -1, n_in > 1 ? in_sizes[1] : -1, out_size, ws_size); grid = -1; return; }
        int dev = 0, cus = 0, per_cu = 0;
        if (hipGetDevice(&dev) != hipSuccess || hipDeviceGetAttribute(&cus, hipDeviceAttributeMultiprocessorCount, dev) != hipSuccess) { grid = -1; return; }
        if (hipFuncSetAttribute((const void*)fwd_kernel, hipFuncAttributeMaxDynamicSharedMemorySize, LDS_BYTES) != hipSuccess) { fprintf(stderr, "kernel_launch: hipFuncSetAttribute failed\n"); grid = -1; return; }
        if (hipOccupancyMaxActiveBlocksPerMultiprocessor(&per_cu, (const void*)fwd_kernel, NWAVES * 64, LDS_BYTES) != hipSuccess || per_cu < 1) { fprintf(stderr, "kernel_launch: occupancy query says %d blocks per CU\n", per_cu); per_cu = 1; }
        (void)hipGetLastError();
        grid = cus * 1;
        if (grid != 256) { fprintf(stderr, "kernel_launch: this build needs 256 compute units (found %d); nothing launched\n", cus); grid = -1; return; }
    }
    if (grid < 0) return;
    (void)hipMemsetAsync((char*)d_ws + WS_CTL, 0, CTL_ZERO_BYTES, stream);
    Args a{};
    for (int i = 0; i < 15; ++i) a.in[i] = (const float*)d_in[i];
    a.out = (float*)d_out; a.ws = (unsigned char*)d_ws;
#if MK_N_LAUNCHES == 1
    a.ph_lo = 0; a.ph_hi = N_PHASES;
    void* kargs[] = {&a};
    hipError_t e = hipLaunchCooperativeKernel((const void*)fwd_kernel, dim3(grid), dim3(NWAVES * 64), kargs, LDS_BYTES, stream);
    if (e != hipSuccess) fprintf(stderr, "kernel_launch: cooperative launch failed: %s (grid %d)\n", hipGetErrorString(e), grid);
#else
    for (int p = 0; p < N_PHASES; ++p) { a.ph_lo = p; a.ph_hi = p + 1; hipLaunchKernelGGL(fwd_kernel, dim3(grid), dim3(NWAVES * 64), LDS_BYTES, stream, a); }
#endif
}
```
